# Optimizing an MI355X kernel written in HIP

```python
import math
import jax, jax.numpy as jnp
from jax import lax
import numpy as np

D_MODEL = 1024
BATCH = 16
SEQ = 4096
DEPTH = 2

CTX_LEN = 256
GRID_W = 64
W_BRANCH = D_MODEL
N_BRANCH = 3
LRU_BLOCKS = 8
LRU_BW = W_BRANCH // LRU_BLOCKS
LRU_C = 8.0
CONV_W = 4
DIFF_HEAD_DIM = 64
DIFF_V_DIM = 2 * DIFF_HEAD_DIM
DIFF_HEADS = W_BRANCH // DIFF_V_DIM
SGU_GROUPS = 8
CHUNK = 128
Q_BLOCK = 128
ROPE_BASE = 10000.0
LN_EPS = 1e-5
RMS_EPS = 1e-5
D_IN = 9 * W_BRANCH + N_BRANCH * D_MODEL
SPLIT_POINTS = tuple(W_BRANCH * i for i in range(1, 10))
f32 = jnp.float32

kernel_name = "hybrid_rglru_diffattn_sgu_diffusion_block"


def layer_norm(x, g, b):
    xf = x.astype(f32)
    mu = jnp.mean(xf, axis=-1, keepdims=True)
    var = jnp.mean(jnp.square(xf - mu), axis=-1, keepdims=True)
    return ((xf - mu) * lax.rsqrt(var + LN_EPS) * g.astype(f32) + b.astype(f32)).astype(x.dtype)


def modulate(h, shift, scale):
    return h * (1 + scale) + shift


def split_proj(h, w_in, b_in):
    z = jnp.einsum('btd,de->bte', h, w_in) + b_in
    return jnp.split(z, SPLIT_POINTS, axis=-1)


def centred_dwconv(x, w, b):
    T = x.shape[1]
    left = CONV_W // 2
    xp = jnp.pad(x, ((0, 0), (left, CONV_W - 1 - left), (0, 0)))
    y = b + xp[:, 0:T] * w[0]
    for k in range(1, CONV_W):
        y = y + xp[:, k:k + T] * w[k]
    return y


def block_diag(x, w):
    B, T, _ = x.shape
    xg = x.reshape(B, T, LRU_BLOCKS, LRU_BW)
    return jnp.einsum('btgi,gij->btgj', xg, w).reshape(B, T, W_BRANCH)


def _lin_comb(e1, e2):
    a1, b1 = e1
    a2, b2 = e2
    return a1 * a2, a2 * b1 + b2


def rglru_scan(xc, w_a, b_a, w_x, b_x, lam, h0, reverse):
    r = jax.nn.sigmoid(block_diag(xc, w_a) + b_a).astype(f32)
    i = jax.nn.sigmoid(block_diag(xc, w_x) + b_x).astype(f32)
    log_a = -LRU_C * r * jax.nn.softplus(-lam.astype(f32))
    a = jnp.exp(log_a)
    bt = jnp.sqrt(-jnp.expm1(2.0 * log_a)) * (i * xc.astype(f32))
    if reverse:
        a, bt = a[:, ::-1], bt[:, ::-1]
    bt = bt.at[:, 0].add(a[:, 0] * h0)
    _, h = lax.associative_scan(_lin_comb, (a, bt), axis=1)
    h_last = h[:, -1]
    if reverse:
        h = h[:, ::-1]
    return h.astype(xc.dtype), h_last


def axial_rope_tables(n_tokens):
    rows = n_tokens // GRID_W
    row = jnp.repeat(jnp.arange(rows), GRID_W).astype(f32)
    col = jnp.tile(jnp.arange(GRID_W), rows).astype(f32)
    nf = DIFF_HEAD_DIM // 4
    freqs = ROPE_BASE ** (-jnp.arange(nf, dtype=f32) / nf)
    ang = jnp.concatenate([row[:, None] * freqs, col[:, None] * freqs], axis=-1)
    return jnp.cos(ang), jnp.sin(ang)


def apply_axial_rope(x, cos, sin):
    T = x.shape[1]
    nf = DIFF_HEAD_DIM // 4
    xr = x.reshape(x.shape[:-1] + (2, 2, nf))
    x1, x2 = xr[..., 0, :], xr[..., 1, :]
    c = cos.reshape(T, 1, 1, 2, nf).astype(x.dtype)
    s = sin.reshape(T, 1, 1, 2, nf).astype(x.dtype)
    out = jnp.stack([x1 * c - x2 * s, x1 * s + x2 * c], axis=-2)
    return out.reshape(x.shape)


def diff_attn_core(q, k, v, lam):
    s = jnp.einsum('bqhmd,bkhmd->bhmqk', q.astype(f32), k.astype(f32)) * (DIFF_HEAD_DIM ** -0.5)
    p = jax.nn.softmax(s, axis=-1)
    w = p[:, :, 0] - lam * p[:, :, 1]
    return jnp.einsum('bhqk,bkhe->bqhe', w, v.astype(f32)).astype(v.dtype)


def latent_diff_attention(q, k_all, v_all, lam):
    B, T = q.shape[:2]
    nblk = T // Q_BLOCK
    qb = q.reshape((B, nblk, Q_BLOCK) + q.shape[2:]).swapaxes(0, 1)
    out = lax.map(lambda qi: diff_attn_core(qi, k_all, v_all, lam), qb)
    return out.swapaxes(0, 1).reshape(B, T, DIFF_HEADS, DIFF_V_DIM)


def diff_head_out(o, g, lam_init):
    of = o.astype(f32)
    of = of * lax.rsqrt(jnp.mean(jnp.square(of), axis=-1, keepdims=True) + RMS_EPS)
    of = of * g.astype(f32) * (1.0 - lam_init)
    B, T = o.shape[:2]
    return of.reshape(B, T, W_BRANCH).astype(o.dtype)


def spatial_gating(u, v, ln_g, ln_b, w_s, b_s):
    B, T, W = v.shape
    vn = layer_norm(v, ln_g, ln_b)
    vc = vn.reshape(B, T // CHUNK, CHUNK, SGU_GROUPS, W // SGU_GROUPS)
    s = jnp.einsum('gpq,bnqgc->bnpgc', w_s, vc) + b_s.T[:, :, None]
    return u * s.reshape(B, T, W)


def merge_branches(h_a, g_a, attn, g_b, sgu, g_c, gates, w_branch, w_out):
    y_a = (h_a * jax.nn.silu(g_a)) @ w_branch[0]
    y_b = (attn * jax.nn.silu(g_b)) @ w_branch[1]
    y_c = (sgu * jax.nn.silu(g_c)) @ w_branch[2]
    s_a, s_b, s_c = jnp.split(jax.nn.sigmoid(gates), N_BRANCH, axis=-1)
    return (s_a * y_a + s_b * y_b + s_c * y_c) @ w_out


def setup_inputs(seed: int = 0) -> dict:
    key = jax.random.key(seed)
    ks = jax.random.split(key, 26)
    L = DEPTH
    beta = (8.0 * DEPTH) ** -0.25

    def nrm(k, shape, s):
        return jax.random.normal(k, shape, f32) * s

    u = jax.random.uniform(ks[14], (L, 2, W_BRANCH), f32, 0.9, 0.999)
    a = u ** (1.0 / LRU_C)
    return {
        "x": nrm(ks[0], (BATCH, SEQ, D_MODEL), 1.0),
        "c": nrm(ks[1], (BATCH, D_MODEL), 1.0),
        "ctx": nrm(ks[2], (BATCH, CTX_LEN, D_MODEL), 1.0),
        "c_ctx": nrm(ks[3], (D_MODEL,), 1.0),
        "w_ada": nrm(ks[4], (L, D_MODEL, 3 * D_MODEL), 0.5 * D_MODEL ** -0.5),
        "b_ada": nrm(ks[5], (L, 3 * D_MODEL), 0.01),
        "w_in": nrm(ks[6], (L, D_MODEL, D_IN), D_MODEL ** -0.5),
        "b_in": nrm(ks[7], (L, D_IN), 0.01),
        "conv_w": nrm(ks[8], (L, CONV_W, W_BRANCH), CONV_W ** -0.5),
        "conv_b": nrm(ks[9], (L, W_BRANCH), 0.01),
        "lru_wa": nrm(ks[10], (L, 2, LRU_BLOCKS, LRU_BW, LRU_BW), LRU_BW ** -0.5),
        "lru_ba": nrm(ks[11], (L, 2, W_BRANCH), 0.01),
        "lru_wx": nrm(ks[12], (L, 2, LRU_BLOCKS, LRU_BW, LRU_BW), LRU_BW ** -0.5),
        "lru_bx": nrm(ks[13], (L, 2, W_BRANCH), 0.01),
        "lru_lambda": jnp.log(a) - jnp.log1p(-a),
        "diff_lambda": nrm(ks[15], (L, 4, DIFF_HEAD_DIM), 0.1),
        "diff_norm_g": 1.0 + nrm(ks[16], (L, DIFF_V_DIM), 0.02),
        "sgu_ln_g": 1.0 + nrm(ks[17], (L, W_BRANCH), 0.02),
        "sgu_ln_b": nrm(ks[18], (L, W_BRANCH), 0.01),
        "sgu_w": nrm(ks[19], (L, SGU_GROUPS, CHUNK, CHUNK), 0.5 * CHUNK ** -0.5),
        "sgu_b": 1.0 + nrm(ks[20], (L, SGU_GROUPS, CHUNK), 0.02),
        "w_branch": nrm(ks[21], (L, N_BRANCH, W_BRANCH, D_MODEL), beta * W_BRANCH ** -0.5),
        "w_out": nrm(ks[22], (L, D_MODEL, D_MODEL), beta * D_MODEL ** -0.5),
        "ln_g": 1.0 + nrm(ks[23], (L, D_MODEL), 0.02),
        "ln_b": nrm(ks[24], (L, D_MODEL), 0.01),
    }


def reference(x, c, ctx, c_ctx, w_ada, b_ada, w_in, b_in, conv_w, conv_b,
              lru_wa, lru_ba, lru_wx, lru_bx, lru_lambda, diff_lambda, diff_norm_g,
              sgu_ln_g, sgu_ln_b, sgu_w, sgu_b, w_branch, w_out, ln_g, ln_b):
    alpha = (2.0 * DEPTH) ** 0.25
    B, T, _ = x.shape
    C = ctx.shape[1]
    cos, sin = axial_rope_tables(T)
    zeros = jnp.zeros((B, W_BRANCH), f32)
    for l in range(DEPTH):
        lam_init = 0.8 - 0.6 * math.exp(-0.3 * l)
        lq1, lk1, lq2, lk2 = diff_lambda[l].astype(f32)
        lam = jnp.exp(jnp.sum(lq1 * lk1)) - jnp.exp(jnp.sum(lq2 * lk2)) + lam_init
        sh_x, sc_x, gt_x = jnp.split((jax.nn.silu(c) @ w_ada[l] + b_ada[l])[:, None, :], 3, axis=-1)
        sh_c, sc_c, gt_c = jnp.split(jax.nn.silu(c_ctx) @ w_ada[l] + b_ada[l], 3, axis=-1)

        pc = split_proj(modulate(ctx, sh_c, sc_c), w_in[l], b_in[l])
        ca = centred_dwconv(pc[0], conv_w[l], conv_b[l])
        hc_f, hf_last = rglru_scan(ca, lru_wa[l, 0], lru_ba[l, 0], lru_wx[l, 0], lru_bx[l, 0],
                                   lru_lambda[l, 0], zeros, False)
        hc_b, hb_last = rglru_scan(ca, lru_wa[l, 1], lru_ba[l, 1], lru_wx[l, 1], lru_bx[l, 1],
                                   lru_lambda[l, 1], zeros, True)
        kc = pc[3].reshape(B, C, DIFF_HEADS, 2, DIFF_HEAD_DIM)
        vc = pc[4].reshape(B, C, DIFF_HEADS, DIFF_V_DIM)

        px = split_proj(modulate(x, sh_x, sc_x), w_in[l], b_in[l])
        xa = centred_dwconv(px[0], conv_w[l], conv_b[l])
        hx_f, _ = rglru_scan(xa, lru_wa[l, 0], lru_ba[l, 0], lru_wx[l, 0], lru_bx[l, 0],
                             lru_lambda[l, 0], hf_last, False)
        hx_b, _ = rglru_scan(xa, lru_wa[l, 1], lru_ba[l, 1], lru_wx[l, 1], lru_bx[l, 1],
                             lru_lambda[l, 1], hb_last, True)
        qx = apply_axial_rope(px[2].reshape(B, T, DIFF_HEADS, 2, DIFF_HEAD_DIM), cos, sin)
        kx = apply_axial_rope(px[3].reshape(B, T, DIFF_HEADS, 2, DIFF_HEAD_DIM), cos, sin)
        vx = px[4].reshape(B, T, DIFF_HEADS, DIFF_V_DIM)
        k_all = jnp.concatenate([kx, kc], axis=1)
        v_all = jnp.concatenate([vx, vc], axis=1)
        attn_x = diff_head_out(latent_diff_attention(qx, k_all, v_all, lam), diff_norm_g[l], lam_init)
        sgu_x = spatial_gating(px[6], px[7], sgu_ln_g[l], sgu_ln_b[l], sgu_w[l], sgu_b[l])
        y_x = merge_branches(hx_f + hx_b, px[1], attn_x, px[5], sgu_x, px[8], px[9],
                             w_branch[l], w_out[l])
        x_new = layer_norm(alpha * x + gt_x * y_x, ln_g[l], ln_b[l])

        if l < DEPTH - 1:
            qc = pc[2].reshape(B, C, DIFF_HEADS, 2, DIFF_HEAD_DIM)
            attn_c = diff_head_out(diff_attn_core(qc, kc, vc, lam), diff_norm_g[l], lam_init)
            sgu_c = spatial_gating(pc[6], pc[7], sgu_ln_g[l], sgu_ln_b[l], sgu_w[l], sgu_b[l])
            y_c = merge_branches(hc_f + hc_b, pc[1], attn_c, pc[5], sgu_c, pc[8], pc[9],
                                 w_branch[l], w_out[l])
            ctx = layer_norm(alpha * ctx + gt_c * y_c, ln_g[l], ln_b[l])
        x = x_new
    return x
```

```cpp
#include <hip/hip_runtime.h>
#include <hip/hip_cooperative_groups.h>
#include <cstdint>
#include <cstdio>
namespace cg = cooperative_groups;

#define LAS __attribute__((address_space(3)))
#define GAS __attribute__((address_space(1)))
typedef unsigned short bf16_t;
typedef short bf16x8 __attribute__((ext_vector_type(8)));
typedef short s16x4 __attribute__((ext_vector_type(4)));
typedef float f32x2 __attribute__((ext_vector_type(2)));
typedef float f32x4 __attribute__((ext_vector_type(4)));
typedef float f32x16 __attribute__((ext_vector_type(16)));
typedef unsigned u32x4 __attribute__((ext_vector_type(4)));
typedef unsigned u32x2 __attribute__((ext_vector_type(2)));
typedef __bf16 bf16x2_t __attribute__((ext_vector_type(2)));

constexpr int D = 1024, NB = 16, T = 4096, CL = 256, NL = 2, DIN = 12288;
constexpr int GB = 4, NGRP = NB / GB;
constexpr int RB = CL + T;
constexpr int RG = GB * RB;
constexpr int TILES_B = RB / 256;
constexpr int TILES_G = RG / 256;
constexpr float ALPHA = 1.41421356237f;
constexpr float C2 = 0.125f * 1.4426950408889634f;
constexpr int NWAVES = 8, NTHR = 512;
constexpr int LDS_BYTES = 147456;
constexpr int LDS_IDX_OFF = 147456 - 64;

constexpr int ZC_AX = 0, ZC_AG = 1024, ZC_Q = 2048, ZC_K = 3072, ZC_V = 4096, ZC_BG = 5120, ZC_CU = 6144, ZC_CV = 7168, ZC_CG = 8192, ZC_MG = 9216;

constexpr size_t MiB = 1u << 20;
constexpr size_t WS_CTL = 0, CTL_BYTES = 65536;
constexpr size_t WS_MOD = 1 * MiB;
constexpr size_t WS_ROPE = 1 * MiB + 512 * 1024;
constexpr size_t WS_SCAL = WS_ROPE + 16384;
constexpr size_t WS_WIN = 2 * MiB;
constexpr size_t WS_WBR = 50 * MiB;
constexpr size_t WS_WOUT = 62 * MiB;
constexpr size_t WS_LRUW = 66 * MiB;
constexpr size_t WS_SGUW = 68 * MiB;
constexpr size_t WS_CTX1 = 70 * MiB;
constexpr size_t WS_XM = 86 * MiB;
constexpr size_t WS_Z = 122 * MiB;
constexpr size_t WS_AIN = 530 * MiB;
constexpr size_t WS_MB = 632 * MiB;
constexpr size_t WS_PB = 666 * MiB;
constexpr size_t WS_SUM = 700 * MiB;
constexpr size_t WS_KC = 704 * MiB;
constexpr size_t WS_VC = 738 * MiB;
constexpr size_t WS_PART = 772 * MiB;
constexpr size_t WS_STATS = 784 * MiB;
constexpr size_t WS_END = 785 * MiB;

__device__ __forceinline__ unsigned pk_bf16(float lo, float hi) { f32x2 v = {lo, hi}; bf16x2_t b = __builtin_convertvector(v, bf16x2_t); return __builtin_bit_cast(unsigned, b); }
__device__ __forceinline__ float bflo(unsigned w) { return __uint_as_float(w << 16); }
__device__ __forceinline__ float bfhi(unsigned w) { return __uint_as_float(w & 0xffff0000u); }
__device__ __forceinline__ float bf1(bf16_t h) { return __uint_as_float((unsigned)h << 16); }
__device__ __forceinline__ bf16_t f2bf(float f) { return (bf16_t)(pk_bf16(f, 0.f) & 0xffffu); }
__device__ __forceinline__ void unpack8(const u32x4 w, float* f) { f[0] = bflo(w.x); f[1] = bfhi(w.x); f[2] = bflo(w.y); f[3] = bfhi(w.y); f[4] = bflo(w.z); f[5] = bfhi(w.z); f[6] = bflo(w.w); f[7] = bfhi(w.w); }
__device__ __forceinline__ float sigmoidf_(float x) { return __builtin_amdgcn_rcpf(1.f + __expf(-x)); }
__device__ __forceinline__ float siluf_(float x) { return x * sigmoidf_(x); }
__device__ __forceinline__ float wave_sum(float v) {
#pragma unroll
    for (int o = 1; o < 64; o <<= 1) v += __shfl_xor(v, o);
    return v;
}
#define LDS_WAIT() asm volatile("s_waitcnt lgkmcnt(0)" ::: "memory")
__device__ __forceinline__ int opq_v(int v) { asm volatile("" : "+v"(v)); return v; }
__device__ __forceinline__ int opq_s(int v) { asm volatile("" : "+s"(v)); return v; }
template <class Tp> __device__ __forceinline__ Tp* opq_p(Tp* p) { asm volatile("" : "+s"(p)); return p; }

namespace pg8 {
constexpr int BM = 256, BK = 64, HALF = 128, HTB = HALF * BK * 2, STAGE_BYTES = 8 * HTB, NXCD = 8, WGM = 4;
__host__ __device__ __forceinline__ int lds_byte(int r, int c) { const int st = (r >> 4) * 2 + (c >> 5), rr = r & 15, cc = c & 31, ob = rr * 64 + cc * 2; return st * 1024 + (ob ^ (((ob >> 9) & 1) << 5)); }
__host__ __device__ __forceinline__ void stage_rc(int b, int& R, int& C) { const int st = b / 1024, sb = b % 1024, swz = sb ^ (((sb >> 9) & 1) << 5); R = (st >> 1) * 16 + swz / 64; C = (st & 1) * 32 + (swz % 64) / 2; }
__host__ __device__ __forceinline__ int perm32(int rho) { const int n = rho >> 4, i = rho & 15; return 8 * (i >> 2) + 4 * n + (i & 3); }

struct Unit { int pm, pn, rm, rn, br, xb; };
struct Gemm { const GAS bf16_t* A; const GAS bf16_t* Bt; int K; };

struct SchedGrid {
    int nM, nN, nwg, G, c;
    __device__ void init(int nM_, int nN_, int G_, int c_) { nM = nM_; nN = nN_; nwg = nM * nN; G = G_; c = c_; }
    __device__ bool next(int i, Unit& u) const {
        const long L = (long)i * G + c; if (L >= nwg) return false;
        int wgid = (int)L; { const int q = nwg / NXCD, r = nwg % NXCD, xcd = wgid % NXCD, off = wgid / NXCD; wgid = (xcd < r ? xcd * (q + 1) : r * (q + 1) + (xcd - r) * q) + off; }
        const int nig = WGM * nN, gid = wgid / nig, fm = gid * WGM, gsz = (nM - fm) < WGM ? (nM - fm) : WGM;
        u.pm = fm + ((wgid % nig) % gsz); u.pn = (wgid % nig) / gsz; u.rm = u.pm; u.rn = u.pn; u.br = 0; u.xb = -1; return true;
    }
};
template <int NBR> struct SchedRows {
    int nrow, G, c; bool skip_ctx, extra;
    __device__ void init(bool skip, int G_, int c_, bool extra_ = false) { skip_ctx = skip; nrow = skip ? GB * 16 : TILES_G; G = G_; c = c_; extra = extra_; }
    __device__ bool next(int i, Unit& u) const {
        const int ti = (i / NBR) * G + c;
        if (ti >= nrow * 4) {
            if (!extra) return false;
            const int ntile = nrow * 4, mine = (c < ntile) ? (ntile - c + G - 1) / G : 0;
            const int x = (i - NBR * mine) * G + c; if (x < 0 || x >= GB * 4 * 3) return false;
            const int et = x / 3, xbr = x % 3, pmc = (et >> 2) * TILES_B, pnc = et & 3;
            u.rm = pmc; u.rn = pnc; u.br = 0; u.xb = xbr; u.pm = xbr * TILES_G + pmc; u.pn = xbr * 4 + pnc; return true;
        }
        const int br = i % NBR, pn = ti & 3, j = ti >> 2;
        const int pm = skip_ctx ? ((j >> 4) * TILES_B + 1 + (j & 15)) : j;
        u.rm = pm; u.rn = pn; u.br = br; u.xb = -1; u.pm = br * TILES_G + pm; u.pn = br * 4 + pn; return true;
    }
};

template <class Epi, class Sched, bool ALIGN_EPI = true, bool SP2 = true>
__device__ __forceinline__ void gemm_phase(LAS unsigned char* lds, const Gemm g, const Sched& S, const Epi& E) {
    const int tid = opq_v(threadIdx.x), wid = __builtin_amdgcn_readfirstlane(tid >> 6), lane = tid & 63, wr = wid >> 2, wc = wid & 3, fr = lane & 15, fq = lane >> 4;
    const int K = g.K, nt = K / BK;
    unsigned voffA[2], voffB[2];
#pragma unroll
    for (int i = 0; i < 2; ++i) { int R, C; stage_rc(tid * 16 + i * 8192, R, C); const int Rb = Epi::PERM ? ((R & ~31) + perm32(R & 31)) : R;
        voffA[i] = (unsigned)(R * K + C) * 2u; voffB[i] = (unsigned)(Rb * K + C) * 2u; }
    const size_t kstep = (size_t)(BK * 2);
    const size_t hstep = (size_t)HALF * K * 2;
    const size_t tstep = 2 * hstep;
    const unsigned ldsw = (unsigned)wid * 1024u;
    const int aoff = lds_byte(wr * 64 + fr, fq * 8), boff = lds_byte(wc * 32 + fr, fq * 8);
#define PG8_SA(b, h) (((b) * 2 + (h)) * HTB)
#define PG8_SB(b, h) ((4 + (b) * 2 + (h)) * HTB)
#define PG8_STAGE(bufoff, gbase, voff) do { _Pragma("unroll") for (int _i = 0; _i < 2; ++_i) \
        __builtin_amdgcn_global_load_lds((const GAS unsigned*)((const GAS char*)(gbase) + (voff)[_i]), (LAS unsigned*)(lds + (bufoff) + ldsw + _i * 8192), 16, 0, 0); } while (0)
#define PG8_LDA(dst, b, h) do { _Pragma("unroll") for (int m = 0; m < 4; ++m) _Pragma("unroll") for (int k = 0; k < 2; ++k) dst[m][k] = *(const LAS bf16x8*)(lds + PG8_SA(b, h) + aoff + m * 2048 + k * 1024); } while (0)
#define PG8_LDB(dst, b, h) do { _Pragma("unroll") for (int n = 0; n < 2; ++n) _Pragma("unroll") for (int k = 0; k < 2; ++k) dst[n][k] = *(const LAS bf16x8*)(lds + PG8_SB(b, h) + boff + n * 2048 + k * 1024); } while (0)
#define PG8_MMA(ai, bj, At, Bt) do { __builtin_amdgcn_s_setprio(1); _Pragma("unroll") for (int m = 0; m < 4; ++m) _Pragma("unroll") for (int n = 0; n < 2; ++n) _Pragma("unroll") for (int k = 0; k < 2; ++k) \
        acc[ai][bj][m][n] = __builtin_amdgcn_mfma_f32_16x16x32_bf16(Bt[n][k], At[m][k], acc[ai][bj][m][n], 0, 0, 0); __builtin_amdgcn_s_setprio(0); } while (0)
#define PG8_WAIT_V(n) asm volatile("s_waitcnt vmcnt(" #n ")" ::: "memory")
#define PG8_WAIT_L(n) asm volatile("s_waitcnt lgkmcnt(" #n ")" ::: "memory")
#define PG8_BAR __builtin_amdgcn_s_barrier()
#define PG8_SCHED __builtin_amdgcn_sched_barrier(0)
    Unit cur, nxt; int ui = 0;
    if (!S.next(0, cur)) return;
    f32x4 acc[2][2][4][2];
#pragma unroll
    for (int a = 0; a < 2; ++a)
#pragma unroll
        for (int b = 0; b < 2; ++b)
#pragma unroll
            for (int m = 0; m < 4; ++m)
#pragma unroll
                for (int n = 0; n < 2; ++n) acc[a][b][m][n] = (f32x4){0.f, 0.f, 0.f, 0.f};
    bf16x8 At[4][2], B0[2][2], B1[2][2];
    const GAS char* cA = (const GAS char*)g.A + (size_t)cur.pm * tstep; const GAS char* cB = (const GAS char*)g.Bt + (size_t)cur.pn * tstep;
    if constexpr (SP2) {
        PG8_STAGE(PG8_SB(0, 0), cB, voffB); PG8_STAGE(PG8_SB(0, 1), cB + hstep, voffB); PG8_STAGE(PG8_SA(0, 0), cA, voffA); PG8_STAGE(PG8_SA(0, 1), cA + hstep, voffA);
        if (wr == 1) PG8_BAR;
        PG8_WAIT_V(2); PG8_BAR;
        PG8_STAGE(PG8_SB(1, 0), cB + kstep, voffB); PG8_STAGE(PG8_SA(1, 0), cA + kstep, voffA); PG8_STAGE(PG8_SB(1, 1), cB + hstep + kstep, voffB);
        PG8_WAIT_V(6); PG8_BAR;
    } else {
        PG8_STAGE(PG8_SB(0, 0), cB, voffB); PG8_STAGE(PG8_SA(0, 0), cA, voffA); PG8_STAGE(PG8_SB(0, 1), cB + hstep, voffB); PG8_STAGE(PG8_SA(0, 1), cA + hstep, voffA);
        if (wr == 1) PG8_BAR;
        PG8_WAIT_V(4); PG8_BAR;
        PG8_STAGE(PG8_SB(1, 0), cB + kstep, voffB); PG8_STAGE(PG8_SA(1, 0), cA + kstep, voffA); PG8_STAGE(PG8_SB(1, 1), cB + hstep + kstep, voffB);
        PG8_WAIT_V(6); PG8_BAR;
    }
    for (;;) {
        const bool has_next = S.next(ui + 1, nxt);
        const GAS char* nA = has_next ? (const GAS char*)g.A + (size_t)nxt.pm * tstep : cA; const GAS char* nB = has_next ? (const GAS char*)g.Bt + (size_t)nxt.pn * tstep : cB;
        for (int t = 0; t < nt; t += 2) {
            const bool last = (t == nt - 2);
            const GAS char* a1 = cA + (size_t)(t + 1) * kstep;
            const GAS char* a2 = last ? nA : cA + (size_t)(t + 2) * kstep; const GAS char* b2 = last ? nB : cB + (size_t)(t + 2) * kstep;
            const GAS char* a3 = a2 + kstep; const GAS char* b3 = b2 + kstep;
            if constexpr (SP2) {
            PG8_LDB(B0, 0, 0); PG8_LDB(B1, 0, 1); PG8_SCHED; PG8_LDA(At, 0, 0); PG8_STAGE(PG8_SA(1, 1), a1 + hstep, voffA);
            PG8_WAIT_V(8); PG8_WAIT_L(0); PG8_BAR; PG8_MMA(0, 0, At, B0); PG8_MMA(0, 1, At, B1); PG8_BAR; PG8_SCHED;
            PG8_LDA(At, 0, 1); PG8_STAGE(PG8_SB(0, 0), b2, voffB); PG8_STAGE(PG8_SB(0, 1), b2 + hstep, voffB); PG8_STAGE(PG8_SA(0, 0), a2, voffA);
            PG8_WAIT_V(8); PG8_WAIT_L(0); PG8_BAR; PG8_MMA(1, 0, At, B0); PG8_MMA(1, 1, At, B1); PG8_BAR; PG8_SCHED;
            PG8_LDB(B0, 1, 0); PG8_LDB(B1, 1, 1); PG8_SCHED; PG8_LDA(At, 1, 0); PG8_STAGE(PG8_SA(0, 1), a2 + hstep, voffA);
            PG8_WAIT_V(8); PG8_WAIT_L(0); PG8_BAR; PG8_MMA(0, 0, At, B0); PG8_MMA(0, 1, At, B1); PG8_BAR; PG8_SCHED;
            PG8_LDA(At, 1, 1); PG8_STAGE(PG8_SB(1, 0), b3, voffB); PG8_STAGE(PG8_SB(1, 1), b3 + hstep, voffB); PG8_STAGE(PG8_SA(1, 0), a3, voffA);
            PG8_WAIT_V(8); PG8_WAIT_L(0); PG8_BAR; PG8_MMA(1, 0, At, B0); PG8_MMA(1, 1, At, B1); PG8_BAR; PG8_SCHED;
            } else {
            PG8_LDB(B0, 0, 0); PG8_SCHED; PG8_LDA(At, 0, 0); PG8_STAGE(PG8_SA(1, 1), a1 + hstep, voffA);
            PG8_WAIT_L(8); PG8_BAR; PG8_WAIT_L(0); PG8_MMA(0, 0, At, B0); PG8_BAR; PG8_SCHED;
            PG8_LDB(B1, 0, 1); PG8_STAGE(PG8_SB(0, 0), b2, voffB);
            PG8_BAR; PG8_WAIT_L(0); PG8_MMA(0, 1, At, B1); PG8_BAR;
            PG8_LDA(At, 0, 1); PG8_STAGE(PG8_SA(0, 0), a2, voffA);
            PG8_BAR; PG8_WAIT_L(0); PG8_MMA(1, 0, At, B0); PG8_BAR; PG8_SCHED;
            PG8_STAGE(PG8_SB(0, 1), b2 + hstep, voffB);
            PG8_WAIT_V(6); PG8_BAR; PG8_MMA(1, 1, At, B1); PG8_BAR;
            PG8_LDB(B0, 1, 0); PG8_SCHED; PG8_LDA(At, 1, 0); PG8_STAGE(PG8_SA(0, 1), a2 + hstep, voffA);
            PG8_WAIT_L(8); PG8_BAR; PG8_WAIT_L(0); PG8_MMA(0, 0, At, B0); PG8_BAR; PG8_SCHED;
            PG8_LDB(B1, 1, 1); PG8_STAGE(PG8_SB(1, 0), b3, voffB);
            PG8_BAR; PG8_WAIT_L(0); PG8_MMA(0, 1, At, B1); PG8_BAR;
            PG8_LDA(At, 1, 1); PG8_STAGE(PG8_SA(1, 0), a3, voffA);
            PG8_BAR; PG8_WAIT_L(0); PG8_MMA(1, 0, At, B0); PG8_BAR; PG8_SCHED;
            PG8_STAGE(PG8_SB(1, 1), b3 + hstep, voffB);
            PG8_WAIT_V(6); PG8_BAR; PG8_MMA(1, 1, At, B1); PG8_BAR;
            }
        }
        if constexpr (ALIGN_EPI) { if (wr == 0) PG8_BAR; }
        E(acc, cur, wr, wc, fr, fq);
        if (!has_next) break;
        if (nxt.br == 0) {
#pragma unroll
        for (int a = 0; a < 2; ++a)
#pragma unroll
            for (int b = 0; b < 2; ++b)
#pragma unroll
                for (int m = 0; m < 4; ++m)
#pragma unroll
                    for (int n = 0; n < 2; ++n) acc[a][b][m][n] = (f32x4){0.f, 0.f, 0.f, 0.f};
        }
        cur = nxt; cA = nA; cB = nB; ++ui;
        if constexpr (ALIGN_EPI) { if (wr == 1) PG8_BAR; }
    }
    PG8_WAIT_V(0);
    if constexpr (!ALIGN_EPI) { if (wr == 0) PG8_BAR; }
    PG8_BAR;
#undef PG8_SA
#undef PG8_SB
#undef PG8_STAGE
#undef PG8_LDA
#undef PG8_LDB
#undef PG8_MMA
#undef PG8_WAIT_V
#undef PG8_WAIT_L
#undef PG8_BAR
#undef PG8_SCHED
}

struct EpiInProj {
    static constexpr bool PERM = true;
    GAS bf16_t* Z; const GAS float* bias; const GAS float* rope; GAS bf16_t* KC; GAS bf16_t* VC;
    __device__ __forceinline__ void operator()(f32x4 (&acc)[2][2][4][2], const Unit& u, int wr, int wc, int fr, int fq) const {
        const int colt = u.rn * BM, cb = colt >> 10, tt = u.rm % TILES_B;
        const int col0 = colt + wc * 32 + 8 * fq;
        const bool do_rope = (tt != 0) && (cb == 2 || cb == 3);
        const float sc = (cb == 2) ? C2 : 1.f;
        f32x4 bv[2][2];
#pragma unroll
        for (int bj = 0; bj < 2; ++bj)
#pragma unroll
            for (int n = 0; n < 2; ++n) bv[bj][n] = *(const GAS f32x4*)(bias + col0 + bj * HALF + 4 * n);
#pragma unroll
        for (int ai = 0; ai < 2; ++ai)
#pragma unroll
            for (int m = 0; m < 4; ++m) {
                const int rit = ai * HALF + wr * 64 + m * 16 + fr;
                GAS bf16_t* rowp = Z + (size_t)(u.rm * BM + rit) * DIN + col0; size_t bjstep = HALF;
                if (cb == 3 || cb == 4) {
                    const int bl_ = u.rm / TILES_B, rib = (u.rm % TILES_B) * BM + rit, cc = col0 & 1023, hh = cc >> 7;
                    if (cb == 3) { rowp = KC + ((size_t)((bl_ * 8 + hh) * 2 + ((cc >> 6) & 1)) * RB + rib) * 64 + (cc & 63); bjstep = (size_t)2 * RB * 64; }
                    else { rowp = VC + ((size_t)(bl_ * 8 + hh) * RB + rib) * 128 + (cc & 127); bjstep = (size_t)RB * 128; } }
                f32x4 cs[4];
                if (do_rope) { const int t = (tt - 1) * 256 + rit; const int pos = (wc & 1) ? (t & 63) : (t >> 6);
                    const GAS f32x4* tp = (const GAS f32x4*)(rope + (pos * 16 + 8 * (fq & 1)) * 2);
                    cs[0] = tp[0]; cs[1] = tp[1]; cs[2] = tp[2]; cs[3] = tp[3]; }
#pragma unroll
                for (int bj = 0; bj < 2; ++bj) {
                    f32x4 v0 = acc[ai][bj][m][0] + bv[bj][0], v1 = acc[ai][bj][m][1] + bv[bj][1];
                    if (do_rope) {
                        float x[8] = {v0[0], v0[1], v0[2], v0[3], v1[0], v1[1], v1[2], v1[3]};
#pragma unroll
                        for (int i = 0; i < 8; ++i) { const float p = __shfl_xor(x[i], 32); const float c = cs[i >> 1][(i & 1) * 2], s = cs[i >> 1][(i & 1) * 2 + 1];
                            x[i] = x[i] * c + ((fq < 2) ? -p * s : p * s); }
                        v0 = (f32x4){x[0], x[1], x[2], x[3]}; v1 = (f32x4){x[4], x[5], x[6], x[7]};
                    }
                    v0 = v0 * sc; v1 = v1 * sc;
                    u32x4 w; w.x = pk_bf16(v0[0], v0[1]); w.y = pk_bf16(v0[2], v0[3]); w.z = pk_bf16(v1[0], v1[1]); w.w = pk_bf16(v1[2], v1[3]);
                    *(GAS u32x4*)(rowp + bj * bjstep) = w;
                }
            }
    }
};
struct EpiMerge {
    static constexpr bool PERM = true;
    const GAS bf16_t* Z; GAS bf16_t* O; GAS float* PART;
    __device__ __forceinline__ void operator()(f32x4 (&acc)[2][2][4][2], const Unit& u, int wr, int wc, int fr, int fq) const {
        const bool part = u.xb >= 0; const int br = part ? u.xb : u.br; const bool fin = part || br == 2;
        const int col0 = u.rn * BM + wc * 32 + 8 * fq;
        const int prow0 = part ? (u.xb * (GB * CL) + (u.rm / TILES_B) * CL) : 0;
#pragma unroll
        for (int ai = 0; ai < 2; ++ai)
#pragma unroll
            for (int m = 0; m < 4; ++m) {
                const int rit = ai * HALF + wr * 64 + m * 16 + fr; const int row = u.rm * BM + rit;
                const GAS bf16_t* zr = Z + (size_t)row * DIN + ZC_MG + col0;
#pragma unroll
                for (int bj = 0; bj < 2; ++bj) {
                    const u32x4 gc = *(const GAS u32x4*)(zr + br * 1024 + bj * HALF);
                    u32x4 gn = (u32x4){0u, 0u, 0u, 0u};
                    if (!fin) gn = *(const GAS u32x4*)(zr + (br + 1) * 1024 + bj * HALF);
                    float c[8], nx[8], r[8]; unpack8(gc, c); unpack8(gn, nx);
#pragma unroll
                    for (int i = 0; i < 8; ++i) { const float den = 1.f + __expf(-c[i]); const float num = fin ? 1.f : 1.f + __expf(-nx[i]); r[i] = num * __builtin_amdgcn_rcpf(den); }
                    f32x4 v0 = acc[ai][bj][m][0] * (f32x4){r[0], r[1], r[2], r[3]}, v1 = acc[ai][bj][m][1] * (f32x4){r[4], r[5], r[6], r[7]};
                    acc[ai][bj][m][0] = v0; acc[ai][bj][m][1] = v1;
                    if (part) { GAS float* pp = PART + (size_t)(prow0 + rit) * D + col0 + bj * HALF; *(GAS f32x4*)pp = v0; *(GAS f32x4*)(pp + 4) = v1; }
                    else if (fin) { u32x4 w; w.x = pk_bf16(v0[0], v0[1]); w.y = pk_bf16(v0[2], v0[3]); w.z = pk_bf16(v1[0], v1[1]); w.w = pk_bf16(v1[2], v1[3]);
                        *(GAS u32x4*)(O + (size_t)row * D + col0 + bj * HALF) = w; }
                }
            }
    }
};
struct EpiOut {
    static constexpr bool PERM = true;
    const GAS float* srcX; const GAS float* srcC; GAS float* dstX; GAS float* dstC; const GAS float* mod; int grp;
    __device__ __forceinline__ void operator()(f32x4 (&acc)[2][2][4][2], const Unit& u, int wr, int wc, int fr, int fq) const {
        const int bl = u.rm / TILES_B, tt = u.rm % TILES_B, b = grp * GB + bl;
        const int col0 = u.rn * BM + wc * 32 + 8 * fq;
        const GAS float* gt = mod + (size_t)(tt == 0 ? 16 : b) * 3072 + 2048 + col0;
        f32x4 gv[2][2];
#pragma unroll
        for (int bj = 0; bj < 2; ++bj)
#pragma unroll
            for (int n = 0; n < 2; ++n) gv[bj][n] = *(const GAS f32x4*)(gt + bj * HALF + 4 * n);
#pragma unroll
        for (int ai = 0; ai < 2; ++ai)
#pragma unroll
            for (int m = 0; m < 4; ++m) {
                const int rit = ai * HALF + wr * 64 + m * 16 + fr;
                const size_t off = (tt == 0) ? ((size_t)(b * CL + rit) * D + col0) : (((size_t)b * T + (tt - 1) * 256 + rit) * D + col0);
                const GAS float* sp = (tt == 0 ? srcC : srcX) + off; GAS float* dp = (tt == 0 ? dstC : dstX) + off;
#pragma unroll
                for (int bj = 0; bj < 2; ++bj)
#pragma unroll
                    for (int n = 0; n < 2; ++n) { const f32x4 xr = *(const GAS f32x4*)(sp + bj * HALF + 4 * n);
                        *(GAS f32x4*)(dp + bj * HALF + 4 * n) = xr * ALPHA + gv[bj][n] * acc[ai][bj][m][n]; }
            }
    }
};
}

struct Params {
    const float* in[25];
    float* out; unsigned char* ws;
};
struct DP { const GAS float* in[25]; GAS float* out; GAS unsigned char* ws; };
enum { I_X = 0, I_C, I_CTX, I_CCTX, I_WADA, I_BADA, I_WIN, I_BIN, I_CONVW, I_CONVB, I_LWA, I_LBA, I_LWX, I_LBX, I_LLAM, I_DLAM, I_DNG, I_SLG, I_SLB, I_SW, I_SB, I_WBR, I_WOUT, I_LNG, I_LNB };

__device__ __forceinline__ void transpose_item(const GAS float* W, int K, int N, GAS bf16_t* WT, float* scr, int item, int lane) {
    const int nblk = N / 32, kb = item / nblk, nb = item % nblk, k0 = 64 * kb, n0 = 32 * nb;
#pragma unroll 8
    for (int i = 0; i < 32; ++i) { const int kk = 2 * i + (lane >> 5); scr[kk * 33 + (lane & 31)] = W[(size_t)(k0 + kk) * N + n0 + (lane & 31)]; }
    LDS_WAIT(); __builtin_amdgcn_wave_barrier();
    const int c = lane & 7;
#pragma unroll
    for (int j = 0; j < 4; ++j) { const int n = (lane >> 3) + 8 * j; const float* s = scr + (8 * c) * 33 + n;
        u32x4 o; o.x = pk_bf16(s[0 * 33], s[1 * 33]); o.y = pk_bf16(s[2 * 33], s[3 * 33]); o.z = pk_bf16(s[4 * 33], s[5 * 33]); o.w = pk_bf16(s[6 * 33], s[7 * 33]);
        *(GAS u32x4*)(WT + (size_t)(n0 + n) * K + k0 + 8 * c) = o; }
    LDS_WAIT(); __builtin_amdgcn_wave_barrier();
}

__device__ __forceinline__ void phase_prologue(const DP& p, unsigned char* smem) {
    const int tid = opq_v(threadIdx.x), lane = tid & 63, wid = tid >> 6;
    GAS unsigned char* ws = p.ws;
    if (blockIdx.x < 48) {
        float* sl = (float*)(smem + 70 * 1024);
        float* part = (float*)smem;
        for (int i = tid; i < 17 * 1024; i += NTHR) { const int bb = i >> 10, k = i & 1023; const float v = (bb < 16) ? p.in[I_C][bb * 1024 + k] : p.in[I_CCTX][k]; sl[i] = siluf_(v); }
        __syncthreads();
        const int l = blockIdx.x / 24, cix = tid & 127, n = (blockIdx.x % 24) * 128 + cix, kq = tid >> 7;
        float acc[17];
#pragma unroll
        for (int bb = 0; bb < 17; ++bb) acc[bb] = 0.f;
        const GAS float* w = p.in[I_WADA] + ((size_t)l * 1024 + kq * 256) * 3072 + n;
        const float* slq = sl + kq * 256;
        for (int k0 = 0; k0 < 256; k0 += 16) {
            float wv[16];
#pragma unroll
            for (int i = 0; i < 16; ++i) wv[i] = w[(size_t)(k0 + i) * 3072];
#pragma unroll
            for (int i = 0; i < 16; ++i)
#pragma unroll
                for (int bb = 0; bb < 17; ++bb) acc[bb] += slq[bb * 1024 + k0 + i] * wv[i];
        }
#pragma unroll
        for (int bb = 0; bb < 17; ++bb) part[(kq * 17 + bb) * 128 + cix] = acc[bb];
        __syncthreads();
        if (kq == 0) {
            const float bias = p.in[I_BADA][l * 3072 + n];
            GAS float* mod = (GAS float*)(ws + WS_MOD);
#pragma unroll
            for (int bb = 0; bb < 17; ++bb) mod[(size_t)(l * 17 + bb) * 3072 + n] = ((part[bb * 128 + cix] + part[(17 + bb) * 128 + cix]) + (part[(34 + bb) * 128 + cix] + part[(51 + bb) * 128 + cix])) + bias;
        }
        __syncthreads();
    }
    if (blockIdx.x == 48) {
        GAS float* rope = (GAS float*)(ws + WS_ROPE);
        for (int i = tid; i < 64 * 16; i += NTHR) { const int pos = i >> 4, f = i & 15; const float fr = powf(10000.f, -(float)f / 16.f); const float ang = (float)pos * fr;
            float s, c; sincosf(ang, &s, &c); rope[i * 2] = c; rope[i * 2 + 1] = s; }
    }
    if (blockIdx.x == 49 && tid < NL) {
        const GAS float* dl = p.in[I_DLAM] + tid * 256; float s1 = 0.f, s2 = 0.f;
        for (int i = 0; i < 64; ++i) { s1 += dl[i] * dl[64 + i]; s2 += dl[128 + i] * dl[192 + i]; }
        const float lam_init = 0.8f - 0.6f * expf(-0.3f * (float)tid);
        ((GAS float*)(ws + WS_SCAL))[tid] = expf(s1) - expf(s2) + lam_init;
    }
    float* scr = (float*)(smem + wid * 8704);
    const int gw = ((int)blockIdx.x - 48) * NWAVES + wid, NGW = ((int)gridDim.x - 48) * NWAVES;
    constexpr int I_IN = 16 * 384, I_SQ = 16 * 32, I_LR = 8;
    constexpr int N_IN = NL * I_IN, N_BR = NL * 3 * I_SQ, N_OUT = NL * I_SQ, N_LR = 64 * I_LR;
    for (int it = (gw >= 0 ? gw : 0x40000000); it < N_IN + N_BR + N_OUT + N_LR; it += NGW) {
        int r = it;
        if (r < N_IN) { const int l = r / I_IN; transpose_item(p.in[I_WIN] + (size_t)l * D * DIN, D, DIN, (GAS bf16_t*)(ws + WS_WIN) + (size_t)l * DIN * D, scr, r % I_IN, lane); continue; } r -= N_IN;
        if (r < N_BR) { const int mi = r / I_SQ; transpose_item(p.in[I_WBR] + (size_t)mi * D * D, D, D, (GAS bf16_t*)(ws + WS_WBR) + (size_t)mi * D * D, scr, r % I_SQ, lane); continue; } r -= N_BR;
        if (r < N_OUT) { const int l = r / I_SQ; transpose_item(p.in[I_WOUT] + (size_t)l * D * D, D, D, (GAS bf16_t*)(ws + WS_WOUT) + (size_t)l * D * D, scr, r % I_SQ, lane); continue; } r -= N_OUT;
        { const int mi = r / I_LR; const int g = mi & 7, gate = (mi >> 3) & 1, ld = mi >> 4;
          const GAS float* src = (gate == 0 ? p.in[I_LWA] : p.in[I_LWX]) + (size_t)(ld * 8 + g) * 16384;
          transpose_item(src, 128, 128, (GAS bf16_t*)(ws + WS_LRUW) + (size_t)mi * 16384, scr, r % I_LR, lane); }
    }
    { GAS bf16_t* sw = (GAS bf16_t*)(ws + WS_SGUW); const GAS float* s = p.in[I_SW];
      for (int i = blockIdx.x * NTHR + tid; i < NL * 8 * 16384 / 2; i += gridDim.x * NTHR) ((GAS unsigned*)sw)[i] = pk_bf16(s[2 * i], s[2 * i + 1]); }
}

__device__ __forceinline__ void phase_xm0(const DP& p, int grp) {
    const int tid = opq_v(threadIdx.x), lane = tid & 63, wid = tid >> 6;
    const int gw = blockIdx.x * NWAVES + wid, NGW = gridDim.x * NWAVES;
    const GAS float* mod = (const GAS float*)(p.ws + WS_MOD);
    GAS bf16_t* xm = (GAS bf16_t*)(p.ws + WS_XM);
    for (int rg = gw; rg < RG; rg += NGW) {
        const int bl = rg / RB, rr = rg % RB, b = grp * GB + bl;
        const GAS float* src = (rr < CL) ? p.in[I_CTX] + (size_t)(b * CL + rr) * D : p.in[I_X] + ((size_t)b * T + rr - CL) * D;
        const GAS float* md = mod + (size_t)(rr < CL ? 16 : b) * 3072;
        GAS u32x2* o = (GAS u32x2*)(xm + (size_t)rg * D) + lane;
#pragma unroll
        for (int j = 0; j < 4; ++j) { const f32x4 v = ((const GAS f32x4*)src)[lane + 64 * j]; const f32x4 sh = ((const GAS f32x4*)md)[lane + 64 * j], sc = ((const GAS f32x4*)(md + 1024))[lane + 64 * j];
            const f32x4 r = v * (sc + 1.f) + sh; u32x2 w; w.x = pk_bf16(r[0], r[1]); w.y = pk_bf16(r[2], r[3]); o[64 * j] = w; }
    }
}
__device__ __forceinline__ void phase_ln(const DP& p, int grp, int l, bool ctx_only = false) {
    const int tid = opq_v(threadIdx.x), lane = tid & 63, wid = tid >> 6;
    const int gw = blockIdx.x * NWAVES + wid, NGW = gridDim.x * NWAVES;
    const GAS float* mod1 = (const GAS float*)(p.ws + WS_MOD) + (size_t)17 * 3072;
    GAS bf16_t* xm = (GAS bf16_t*)(p.ws + WS_XM);
    const GAS float* lg = p.in[I_LNG] + l * D; const GAS float* lb = p.in[I_LNB] + l * D;
    f32x4 g4[4], b4[4];
#pragma unroll
    for (int j = 0; j < 4; ++j) { g4[j] = ((const GAS f32x4*)lg)[lane + 64 * j]; b4[j] = ((const GAS f32x4*)lb)[lane + 64 * j]; }
    const int n_rows = ctx_only ? GB * CL : ((l == 0) ? RG : GB * T);
#define LN_ROW(i, rgv, bufv, bbv) do { int rg_, rr_; if (ctx_only) { rr_ = (i) % CL; rg_ = ((i) / CL) * RB + rr_; } else if (l == 0) { rg_ = (i); rr_ = rg_ % RB; } else { rr_ = CL + ((i) % T); rg_ = ((i) / T) * RB + rr_; } const int b_ = grp * GB + rg_ / RB; \
        rgv = rg_; bbv = (rr_ < CL) ? 16 : b_; bufv = (rr_ < CL) ? (GAS float*)(p.ws + WS_CTX1) + (size_t)(b_ * CL + rr_) * D : p.out + ((size_t)b_ * T + rr_ - CL) * D; } while (0)
    f32x4 nv[4]; int nrg = 0, nbb = 0; GAS float* nbuf = nullptr;
    if (gw < n_rows) { LN_ROW(gw, nrg, nbuf, nbb);
#pragma unroll
        for (int j = 0; j < 4; ++j) nv[j] = ((const GAS f32x4*)nbuf)[lane + 64 * j]; }
    for (int i = gw; i < n_rows; i += NGW) {
        const int rg = nrg, bb = nbb; GAS float* buf = nbuf;
        f32x4 v[4]; float s = 0.f;
#pragma unroll
        for (int j = 0; j < 4; ++j) { v[j] = nv[j]; s += (v[j][0] + v[j][1]) + (v[j][2] + v[j][3]); }
        if (i + NGW < n_rows) { LN_ROW(i + NGW, nrg, nbuf, nbb);
#pragma unroll
            for (int j = 0; j < 4; ++j) nv[j] = ((const GAS f32x4*)nbuf)[lane + 64 * j]; }
        const float mean = wave_sum(s) * (1.f / D); float s2 = 0.f;
#pragma unroll
        for (int j = 0; j < 4; ++j) { v[j] = v[j] - mean; s2 += (v[j][0] * v[j][0] + v[j][1] * v[j][1]) + (v[j][2] * v[j][2] + v[j][3] * v[j][3]); }
        const float rstd = 1.f / sqrtf(wave_sum(s2) * (1.f / D) + 1e-5f);
#pragma unroll
        for (int j = 0; j < 4; ++j) { v[j] = v[j] * rstd * g4[j] + b4[j]; ((GAS f32x4*)buf)[lane + 64 * j] = v[j]; }
        if (l == 0) {
            const GAS float* md = mod1 + (size_t)bb * 3072;
            GAS u32x2* o = (GAS u32x2*)(xm + (size_t)rg * D) + lane;
#pragma unroll
            for (int j = 0; j < 4; ++j) { const f32x4 sh = ((const GAS f32x4*)md)[lane + 64 * j], sc = ((const GAS f32x4*)(md + 1024))[lane + 64 * j];
                const f32x4 r = v[j] * (sc + 1.f) + sh; u32x2 w; w.x = pk_bf16(r[0], r[1]); w.y = pk_bf16(r[2], r[3]); o[64 * j] = w; }
        }
    }
#undef LN_ROW
}

__device__ __forceinline__ int crow(int r, int hi) { return (r & 3) + 8 * (r >> 2) + 4 * hi; }
typedef short v4i16_t __attribute__((ext_vector_type(4)));
__device__ __forceinline__ s16x4 vtr(LAS const unsigned char* p) { return __builtin_bit_cast(s16x4, __builtin_amdgcn_ds_read_tr16_b64_v4i16((LAS v4i16_t*)p)); }
__device__ __forceinline__ void glds16(const GAS void* gsrc, unsigned lds_dst) { unsigned keep;
    asm volatile("s_mov_b32 %0, m0\n\ts_mov_b32 m0, %2\n\ts_nop 0\n\tglobal_load_lds_dwordx4 %1, off\n\ts_mov_b32 m0, %0" : "=&s"(keep) : "v"(gsrc), "s"(lds_dst) : "memory"); }
__device__ __forceinline__ void glds16s(unsigned long long sbase, unsigned voff, unsigned lds_dst) { unsigned keep;
    asm volatile("s_mov_b32 %0, m0\n\ts_mov_b32 m0, %3\n\ts_nop 0\n\tglobal_load_lds_dwordx4 %1, %2\n\ts_mov_b32 m0, %0" : "=&s"(keep) : "v"(voff), "s"(sbase), "s"(lds_dst) : "memory"); }
__device__ __forceinline__ unsigned long long uni64(unsigned long long v) { return ((unsigned long long)(unsigned)__builtin_amdgcn_readfirstlane((int)(v >> 32)) << 32) | (unsigned)__builtin_amdgcn_readfirstlane((int)(unsigned)v); }
#define WAIT_BAR(N) asm volatile("s_waitcnt vmcnt(" #N ") lgkmcnt(0)\n\ts_barrier" ::: "memory")
#define MX3(a, b, c) __builtin_fmaxf(__builtin_fmaxf((a), (b)), (c))
#define SBAR() __builtin_amdgcn_sched_barrier(0)

constexpr int AT_K = 0, AT_V = 40960, AT_SCR = 122880;
__device__ __forceinline__ void attn_unit(const DP& p, unsigned char* smem, int l, int bl, int h, int qb) {
    const int tid = opq_v(threadIdx.x), lane = tid & 63, r32 = lane & 31, hi = lane >> 5; const int wid = __builtin_amdgcn_readfirstlane(tid >> 6);
    LAS unsigned char* lds3 = (LAS unsigned char*)smem;
    const GAS bf16_t* z = (const GAS bf16_t*)(p.ws + WS_Z);
    GAS bf16_t* bin = (GAS bf16_t*)(p.ws + WS_AIN) + (size_t)RG * D;
    const int rowb = bl * RB, qrow0 = rowb + qb * 256 + wid * 32;
    const int NT = (qb == 0) ? 4 : 68;
    const float lam = ((const GAS float*)(p.ws + WS_SCAL))[l];
    const float lam_init = 0.8f - 0.6f * expf(-0.3f * (float)l);
    float* scr = (float*)(smem + AT_SCR) + wid * 64;
    unsigned ofp[4][8];
    const int vcol = ZC_V + h * 128;
    const unsigned long long vbase = uni64((unsigned long long)(size_t)(p.ws + WS_VC) + ((size_t)(bl * 8 + h) * RB) * 256);
    const unsigned voffV = (unsigned)(((16 * (wid & 3) + (lane >> 2)) * 128 + (wid >> 2) * 32 + (lane & 3) * 8) * 2);
    const unsigned voffK = (unsigned)((lane * 64 + wid * 8) * 2);
    LAS const unsigned char* vp0 = lds3 + AT_V + ((lane >> 4) & 1) * 32 + (lane & 3) * 8 + (4 * hi + ((lane & 15) >> 2)) * 64;
    const unsigned lds0 = (unsigned)(size_t)lds3;
    const unsigned kdst = (unsigned)__builtin_amdgcn_readfirstlane(lds0 + AT_K + wid * 1024);
    const unsigned vdst = (unsigned)__builtin_amdgcn_readfirstlane(lds0 + AT_V + wid * 1024);
    f32x16 o[4];
    for (int mp = 0; mp < 2; ++mp) {
        bf16x8 qr[4];
        { const GAS bf16_t* qp = z + (size_t)(qrow0 + r32) * DIN + ZC_Q + h * 128 + mp * 64 + hi * 8;
#pragma unroll
          for (int d0 = 0; d0 < 4; ++d0) qr[d0] = *(const GAS bf16x8*)(qp + d0 * 16); }
        const unsigned long long kbase = uni64((unsigned long long)(size_t)(p.ws + WS_KC) + ((size_t)((bl * 8 + h) * 2 + mp) * RB) * 128);
#pragma unroll
        for (int e = 0; e < 4; ++e) o[e] = f32x16{};
        float mrun = 0.f, lsum = 0.f; f32x16 negm = f32x16{};
#pragma unroll
        for (int u = 0; u < 4; ++u) { glds16s(kbase + (unsigned long long)u * 8192, voffK, kdst + u * 8192); glds16s(vbase + (unsigned long long)u * 16384, voffV, vdst + u * 16384); glds16s(vbase + (unsigned long long)u * 16384, voffV + 128, vdst + u * 16384 + 8192); }
        WAIT_BAR(9);
        int cur = 0;
        for (int t = 0; t < NT; ++t) {
            if (t + 4 < NT) { const unsigned long long kb4 = kbase + (unsigned long long)(t + 4) * 8192, vb4 = vbase + (unsigned long long)(t + 4) * 16384; const int nb = (cur >= 1) ? cur - 1 : 4;
                glds16s(kb4, voffK, kdst + nb * 8192); glds16s(vb4, voffV, vdst + nb * 16384); glds16s(vb4, voffV + 128, vdst + nb * 16384 + 8192); }
            LAS const unsigned char* kb = lds3 + AT_K + cur * 8192 + hi * 1024 + r32 * 16;
            LAS const unsigned char* vp = vp0 + cur * 16384;
            bf16x8 kf[8];
#pragma unroll
            for (int d0 = 0; d0 < 4; ++d0) { kf[2 * d0] = *(const LAS bf16x8*)(kb + d0 * 2048); kf[2 * d0 + 1] = *(const LAS bf16x8*)(kb + d0 * 2048 + 512); }
            s16x4 va[8], vb[8];
            SBAR();
            f32x16 p0, p1;
            p0 = __builtin_amdgcn_mfma_f32_32x32x16_bf16(kf[0], qr[0], negm, 0, 0, 0); p1 = __builtin_amdgcn_mfma_f32_32x32x16_bf16(kf[1], qr[0], negm, 0, 0, 0);
#pragma unroll
            for (int d0 = 1; d0 < 4; ++d0) { p0 = __builtin_amdgcn_mfma_f32_32x32x16_bf16(kf[2 * d0], qr[d0], p0, 0, 0, 0); p1 = __builtin_amdgcn_mfma_f32_32x32x16_bf16(kf[2 * d0 + 1], qr[d0], p1, 0, 0, 0); }
            float mx;
            { float a = MX3(p0[0], p0[1], p1[0]), b = MX3(p0[2], p0[3], p1[1]); a = MX3(a, p1[2], p1[3]);
#pragma unroll
              for (int r = 4; r < 16; r += 4) { a = MX3(a, p0[r], p0[r + 1]); b = MX3(b, p0[r + 2], p0[r + 3]); a = MX3(a, p1[r], p1[r + 1]); b = MX3(b, p1[r + 2], p1[r + 3]); }
              mx = fmaxf(a, b); mx = fmaxf(mx, __shfl_xor(mx, 32)); }
            if (t == 0 || __any(mx > 8.f)) {
                const float dl = (t == 0) ? mx : fmaxf(mx, 0.f); const float f = (t == 0) ? 1.f : __builtin_amdgcn_exp2f(-dl); mrun += dl; lsum *= f;
#pragma unroll
                for (int r = 0; r < 16; ++r) { p0[r] -= dl; p1[r] -= dl; negm[r] = -mrun; }
                if (hi == 0) scr[r32] = f;
                LDS_WAIT(); __builtin_amdgcn_wave_barrier();
#pragma unroll
                for (int r = 0; r < 16; ++r) { const float fr_ = scr[crow(r, hi)];
#pragma unroll
                    for (int e = 0; e < 4; ++e) o[e][r] *= fr_; }
                LDS_WAIT(); __builtin_amdgcn_wave_barrier();
            }
            f32x2 sacc2 = {0.f, 0.f}; u32x4 pw[4];
#define EXPPAIR(P, base, c, j) do { const float x0_ = __builtin_amdgcn_exp2f(P[(base) + 2 * (j)]), x1_ = __builtin_amdgcn_exp2f(P[(base) + 2 * (j) + 1]); sacc2 += (f32x2){x0_, x1_}; pw[c][j] = pk_bf16(x0_, x1_); } while (0)
#define VLOADK(F, ks) do { _Pragma("unroll") for (int e = 0; e < 4; ++e) { F[2 * e] = vtr(vp + e * 4096 + (ks) * 1024); F[2 * e + 1] = vtr(vp + e * 4096 + (ks) * 1024 + 512); } } while (0)
#define FR(F, e) ((bf16x8){F[2 * (e)][0], F[2 * (e)][1], F[2 * (e)][2], F[2 * (e)][3], F[2 * (e) + 1][0], F[2 * (e) + 1][1], F[2 * (e) + 1][2], F[2 * (e) + 1][3]})
#define PVK(F, c, e) o[e] = __builtin_amdgcn_mfma_f32_32x32x16_bf16(__builtin_bit_cast(bf16x8, pw[c]), FR(F, e), o[e], 0, 0, 0)
            VLOADK(va, 0);
            EXPPAIR(p0, 0, 0, 0); EXPPAIR(p0, 0, 0, 1); EXPPAIR(p0, 0, 0, 2); EXPPAIR(p0, 0, 0, 3);
            SBAR();
            VLOADK(vb, 1);
            PVK(va, 0, 0); EXPPAIR(p0, 8, 1, 0); SBAR(); PVK(va, 0, 1); EXPPAIR(p0, 8, 1, 1); SBAR(); PVK(va, 0, 2); EXPPAIR(p0, 8, 1, 2); SBAR(); PVK(va, 0, 3); EXPPAIR(p0, 8, 1, 3); SBAR();
            VLOADK(va, 2);
            PVK(vb, 1, 0); EXPPAIR(p1, 0, 2, 0); SBAR(); PVK(vb, 1, 1); EXPPAIR(p1, 0, 2, 1); SBAR(); PVK(vb, 1, 2); EXPPAIR(p1, 0, 2, 2); SBAR(); PVK(vb, 1, 3); EXPPAIR(p1, 0, 2, 3); SBAR();
            VLOADK(vb, 3);
            PVK(va, 2, 0); EXPPAIR(p1, 8, 3, 0); SBAR(); PVK(va, 2, 1); EXPPAIR(p1, 8, 3, 1); SBAR(); PVK(va, 2, 2); EXPPAIR(p1, 8, 3, 2); SBAR(); PVK(va, 2, 3); EXPPAIR(p1, 8, 3, 3); SBAR();
            PVK(vb, 3, 0); PVK(vb, 3, 1); PVK(vb, 3, 2); PVK(vb, 3, 3); SBAR();
            lsum += sacc2[0] + sacc2[1];
#undef EXPPAIR
#undef VLOADK
#undef FR
#undef PVK
            if (t + 4 < NT) WAIT_BAR(9); else if (t + 3 < NT) WAIT_BAR(6); else if (t + 2 < NT) WAIT_BAR(3); else WAIT_BAR(0);
            cur = (cur == 4) ? 0 : cur + 1;
        }
        const float ltot = lsum + __shfl_xor(lsum, 32);
        if (hi == 0) scr[r32] = 1.f / ltot;
        LDS_WAIT(); __builtin_amdgcn_wave_barrier();
        if (mp == 0) {
#pragma unroll
            for (int r = 0; r < 16; r += 2) { const float rl0 = scr[crow(r, hi)], rl1 = scr[crow(r + 1, hi)];
#pragma unroll
                for (int e = 0; e < 4; ++e) ofp[e][r >> 1] = pk_bf16(o[e][r] * rl0, o[e][r + 1] * rl1); }
        } else {
#pragma unroll
            for (int r = 0; r < 16; ++r) { const float rl = scr[crow(r, hi)];
#pragma unroll
                for (int e = 0; e < 4; ++e) { const float o0 = (r & 1) ? bfhi(ofp[e][r >> 1]) : bflo(ofp[e][r >> 1]); o[e][r] = o0 - lam * (o[e][r] * rl); } }
        }
        LDS_WAIT(); __builtin_amdgcn_wave_barrier();
    }
    float ss[16];
#pragma unroll
    for (int r = 0; r < 16; ++r) { float s = 0.f;
#pragma unroll
        for (int e = 0; e < 4; ++e) s += o[e][r] * o[e][r];
        ss[r] = s; }
#pragma unroll
    for (int off = 1; off < 32; off <<= 1)
#pragma unroll
        for (int r = 0; r < 16; ++r) ss[r] += __shfl_xor(ss[r], off);
    const GAS float* ng = p.in[I_DNG] + l * 128;
    float gn[4];
#pragma unroll
    for (int e = 0; e < 4; ++e) gn[e] = ng[32 * e + r32] * (1.f - lam_init);
#pragma unroll
    for (int r = 0; r < 16; ++r) {
        const float sc = 1.f / sqrtf(ss[r] * (1.f / 128.f) + 1e-5f);
        const int row = qrow0 + crow(r, hi);
#pragma unroll
        for (int e = 0; e < 4; ++e) { const int col = h * 128 + 32 * e + r32; const float gate = bf1(z[(size_t)row * DIN + ZC_BG + col]);
            bin[(size_t)row * D + col] = f2bf(o[e][r] * sc * gn[e] * siluf_(gate)); }
    }
}
#undef MX3
#undef SBAR

constexpr int LR_RAW = 0;
constexpr int LR_XC = 34816;
constexpr int LR_O1 = 69632;
constexpr int LR_O2 = 104448;
template <int DIR> __device__ __forceinline__ void lru_scan_chunk(const float (&av)[8][4], const float (&bv)[8][4], float (&hv)[8][4], float (&pv)[8][4], float& ptot, float& hend, int lane) {
    const int q = lane >> 4;
    float A1[8][4], B1[8][4], EA[8], EB[8], TA[8], TB[8];
#pragma unroll
    for (int m = 0; m < 8; ++m) {
        if (DIR == 0) { A1[m][0] = av[m][0]; B1[m][0] = bv[m][0];
#pragma unroll
            for (int j = 1; j < 4; ++j) { A1[m][j] = av[m][j] * A1[m][j - 1]; B1[m][j] = av[m][j] * B1[m][j - 1] + bv[m][j]; } }
        else { A1[m][3] = av[m][3]; B1[m][3] = bv[m][3];
#pragma unroll
            for (int j = 2; j >= 0; --j) { A1[m][j] = av[m][j] * A1[m][j + 1]; B1[m][j] = av[m][j] * B1[m][j + 1] + bv[m][j]; } }
        float IA = (DIR == 0) ? A1[m][3] : A1[m][0], IB = (DIR == 0) ? B1[m][3] : B1[m][0];
#pragma unroll
        for (int s = 1; s <= 2; s <<= 1) {
            const int src = (DIR == 0) ? lane - 16 * s : lane + 16 * s;
            const float pa = __shfl(IA, src & 63), pb = __shfl(IB, src & 63);
            const bool ok = (DIR == 0) ? (q >= s) : (q + s <= 3);
            if (ok) { IB = IA * pb + IB; IA = IA * pa; }
        }
        { const int src = (DIR == 0) ? lane - 16 : lane + 16; const float ea = __shfl(IA, src & 63), eb = __shfl(IB, src & 63);
          const bool first = (DIR == 0) ? (q == 0) : (q == 3); EA[m] = first ? 1.f : ea; EB[m] = first ? 0.f : eb; }
        { const int src = (DIR == 0) ? 48 + (lane & 15) : (lane & 15); TA[m] = __shfl(IA, src); TB[m] = __shfl(IB, src); }
    }
    float hin = 0.f, pin = 1.f;
#pragma unroll
    for (int mm = 0; mm < 8; ++mm) { const int m = (DIR == 0) ? mm : 7 - mm;
        const float hq = EA[m] * hin + EB[m], aq = EA[m] * pin;
#pragma unroll
        for (int j = 0; j < 4; ++j) { hv[m][j] = A1[m][j] * hq + B1[m][j]; pv[m][j] = A1[m][j] * aq; }
        hin = TA[m] * hin + TB[m]; pin = TA[m] * pin; }
    ptot = pin; hend = hin;
}

struct LruW { bf16x8 fa[4], fx[4]; float ba, bx, lm; };
__device__ __forceinline__ void lru_load_w(const DP& p, int l, int dir, int g, int lane, int wid, LruW& w) {
    const int ld = l * 2 + dir;
    const GAS bf16_t* wa = (const GAS bf16_t*)(p.ws + WS_LRUW) + (size_t)((ld * 2 + 0) * 8 + g) * 16384 + (size_t)(16 * wid + (lane & 15)) * 128 + (lane >> 4) * 8;
    const GAS bf16_t* wx = wa + (size_t)8 * 16384;
#pragma unroll
    for (int ks = 0; ks < 4; ++ks) { w.fa[ks] = *(const GAS bf16x8*)(wa + ks * 32); w.fx[ks] = *(const GAS bf16x8*)(wx + ks * 32); }
    const int ch = g * 128 + 16 * wid + (lane & 15);
    w.ba = p.in[I_LBA][ld * D + ch]; w.bx = p.in[I_LBX][ld * D + ch]; w.lm = p.in[I_LLAM][ld * D + ch];
}
template <int DIR> __device__ __forceinline__ void lru_dir(const DP& p, unsigned char* smem, int l, int bl, int g, int cidx, float (&hsum)[8][4], int lane, int wid, const LruW& w) {
    const bf16_t* xcs = (const bf16_t*)(smem + LR_XC);
    bf16_t* po = (bf16_t*)(smem + (DIR == 0 ? LR_O1 : LR_O2));
    const bf16x8 (&fa)[4] = w.fa; const bf16x8 (&fx)[4] = w.fx;
    const int ch = g * 128 + 16 * wid + (lane & 15);
    const float ba = w.ba, bx = w.bx;
    float cl; { const float x = __expf(-w.lm); cl = 8.f * ((x < 0.05f) ? x * (1.f + x * (-0.5f + x * (0.33333334f - 0.25f * x))) : __logf(1.f + x)); }
    f32x4 ar[8], ai_[8];
#pragma unroll
    for (int m = 0; m < 8; ++m) { ar[m] = (f32x4){0.f, 0.f, 0.f, 0.f}; ai_[m] = (f32x4){0.f, 0.f, 0.f, 0.f}; }
#pragma unroll
    for (int m = 0; m < 8; ++m)
#pragma unroll
        for (int ks = 0; ks < 4; ++ks) { const bf16x8 af = *(const bf16x8*)(xcs + (16 * m + (lane & 15)) * 136 + ks * 32 + (lane >> 4) * 8);
            ar[m] = __builtin_amdgcn_mfma_f32_16x16x32_bf16(af, fa[ks], ar[m], 0, 0, 0); ai_[m] = __builtin_amdgcn_mfma_f32_16x16x32_bf16(af, fx[ks], ai_[m], 0, 0, 0); }
    float av[8][4], bv[8][4], hv[8][4], pv[8][4];
#pragma unroll
    for (int m = 0; m < 8; ++m)
#pragma unroll
        for (int j = 0; j < 4; ++j) { const int tt = 16 * m + 4 * (lane >> 4) + j; const float xc = bf1(xcs[tt * 136 + 16 * wid + (lane & 15)]);
            const float r = sigmoidf_(ar[m][j] + ba), ii = sigmoidf_(ai_[m][j] + bx);
            const float la = -cl * r; const float a = __expf(la); const float mult = __builtin_amdgcn_sqrtf(fmaxf(1.f - a * a, 0.f));
            av[m][j] = a; bv[m][j] = mult * ii * xc; }
    float ptot, hend;
    lru_scan_chunk<DIR>(av, bv, hv, pv, ptot, hend, lane);
#pragma unroll
    for (int m = 0; m < 8; ++m)
#pragma unroll
        for (int j = 0; j < 4; ++j) { const int tt = 16 * m + 4 * (lane >> 4) + j; po[tt * 136 + 16 * wid + (lane & 15)] = f2bf(pv[m][j]);
            if (DIR == 0) hsum[m][j] = hv[m][j]; else hsum[m][j] += hv[m][j]; }
    if (lane < 16) { GAS f32x2* sp = (GAS f32x2*)(p.ws + WS_SUM) + ((size_t)((bl * 2 + DIR) * 34 + cidx)) * D + ch; *sp = (f32x2){ptot, hend}; }
}

__device__ __forceinline__ void lru_s1_item(const DP& p, unsigned char* smem, int l, int bl, int g, int cidx) {
    const int tid = opq_v(threadIdx.x), lane = tid & 63; const int wid = __builtin_amdgcn_readfirstlane(tid >> 6);
    const GAS bf16_t* z = (const GAS bf16_t*)(p.ws + WS_Z);
    const int rowb = bl * RB;
    bf16_t* raw = (bf16_t*)(smem + LR_RAW); bf16_t* xcs = (bf16_t*)(smem + LR_XC);
    const int c8 = (tid & 15) * 8;
    const bool is_ctx = cidx < 2; const int seqbase = rowb + (is_ctx ? 0 : CL), Tseq = is_ctx ? CL : T, t0 = is_ctx ? cidx * 128 : (cidx - 2) * 128;
    LruW w0, w1;
    lru_load_w(p, l, 0, g, lane, wid, w0); lru_load_w(p, l, 1, g, lane, wid, w1);
    { u32x4 rv[5];
#pragma unroll
      for (int k = 0; k < 5; ++k) { const int i = tid + k * NTHR; const int rr = i >> 4, cc = (i & 15) * 8; const int t = t0 - 2 + rr;
          rv[k] = (u32x4){0u, 0u, 0u, 0u};
          if (i < 132 * 16 && t >= 0 && t < Tseq) rv[k] = *(const GAS u32x4*)(z + (size_t)(seqbase + t) * DIN + ZC_AX + g * 128 + cc); }
#pragma unroll
      for (int k = 0; k < 5; ++k) { const int i = tid + k * NTHR; const int rr = i >> 4, cc = (i & 15) * 8; if (i < 132 * 16) *(u32x4*)(raw + rr * 128 + cc) = rv[k]; } }
    float cw[4][8], cbv[8];
    { const GAS float* w = p.in[I_CONVW] + (size_t)l * 4 * D + g * 128 + c8; const GAS float* b = p.in[I_CONVB] + l * D + g * 128 + c8;
#pragma unroll
      for (int k = 0; k < 4; ++k)
#pragma unroll
          for (int i = 0; i < 8; ++i) cw[k][i] = w[k * D + i];
#pragma unroll
      for (int i = 0; i < 8; ++i) cbv[i] = b[i]; }
    __syncthreads();
#pragma unroll
    for (int j = 0; j < 4; ++j) { const int idx = tid + NTHR * j; const int tt = idx >> 4;
        float accv[8];
#pragma unroll
        for (int i = 0; i < 8; ++i) accv[i] = cbv[i];
#pragma unroll
        for (int k = 0; k < 4; ++k) { float xv[8]; unpack8(*(const u32x4*)(raw + (tt + k) * 128 + c8), xv);
#pragma unroll
            for (int i = 0; i < 8; ++i) accv[i] += xv[i] * cw[k][i]; }
        u32x4 w; w.x = pk_bf16(accv[0], accv[1]); w.y = pk_bf16(accv[2], accv[3]); w.z = pk_bf16(accv[4], accv[5]); w.w = pk_bf16(accv[6], accv[7]);
        *(u32x4*)(xcs + tt * 136 + c8) = w; }
    __syncthreads();
    float hsum[8][4];
    lru_dir<0>(p, smem, l, bl, g, cidx, hsum, lane, wid, w0);
    lru_dir<1>(p, smem, l, bl, g, cidx, hsum, lane, wid, w1);
    { bf16_t* o0 = (bf16_t*)(smem + LR_RAW);
#pragma unroll
      for (int m = 0; m < 8; ++m)
#pragma unroll
          for (int j = 0; j < 4; ++j) { const int tt = 16 * m + 4 * (lane >> 4) + j; o0[tt * 136 + 16 * wid + (lane & 15)] = f2bf(hsum[m][j]); } }
    __syncthreads();
    { GAS bf16_t* ain = (GAS bf16_t*)(p.ws + WS_AIN); GAS bf16_t* pfb = (GAS bf16_t*)(p.ws + WS_MB); GAS bf16_t* pbb = (GAS bf16_t*)(p.ws + WS_PB);
#pragma unroll
      for (int j = 0; j < 4; ++j) { const int idx = tid + NTHR * j; const int tt = idx >> 4;
          const size_t off = (size_t)(seqbase + t0 + tt) * D + g * 128 + c8;
          *(GAS u32x4*)(ain + off) = *(const u32x4*)(smem + LR_RAW + (tt * 136 + c8) * 2);
          *(GAS u32x4*)(pfb + off) = *(const u32x4*)(smem + LR_O1 + (tt * 136 + c8) * 2);
          *(GAS u32x4*)(pbb + off) = *(const u32x4*)(smem + LR_O2 + (tt * 136 + c8) * 2); } }
    __syncthreads();
}

__device__ __forceinline__ void lru_combine_item(const DP& p, unsigned char* smem, int bl, int cidx, int g) {
    const int tid = opq_v(threadIdx.x);
    const GAS bf16_t* z = (const GAS bf16_t*)(p.ws + WS_Z);
    GAS bf16_t* ain = (GAS bf16_t*)(p.ws + WS_AIN); const GAS bf16_t* pfb = (const GAS bf16_t*)(p.ws + WS_MB); const GAS bf16_t* pbb = (const GAS bf16_t*)(p.ws + WS_PB);
    float* cin = (float*)smem;
    const int row0 = bl * RB + (cidx < 2 ? cidx * 128 : CL + (cidx - 2) * 128);
    const int c8 = (tid & 15) * 8;
    u32x4 ru[4], rpf[4], rpb[4], rgt[4];
#pragma unroll
    for (int j = 0; j < 4; ++j) { const int tt = (tid + NTHR * j) >> 4; const size_t grow = (size_t)(row0 + tt); const size_t off = grow * D + g * 128 + c8;
        ru[j] = *(const GAS u32x4*)(ain + off); rpf[j] = *(const GAS u32x4*)(pfb + off); rpb[j] = *(const GAS u32x4*)(pbb + off); rgt[j] = *(const GAS u32x4*)(z + grow * DIN + ZC_AG + g * 128 + c8); }
    if (tid < 256) { const int dir = tid >> 7, chl = tid & 127;
        const GAS f32x2* S = (const GAS f32x2*)(p.ws + WS_SUM) + (size_t)((bl * 2 + dir) * 34) * D + g * 128 + chl;
        const int npos = (dir == 0) ? cidx : ((cidx < 2) ? 1 - cidx : 35 - cidx);
        f32x2 sv[34];
#pragma unroll
        for (int k = 0; k < 34; ++k) { const int cc = (dir == 0) ? k : ((k < 2) ? 1 - k : 35 - k); sv[k] = (k < npos) ? S[(size_t)cc * D] : (f32x2){1.f, 0.f}; }
        float h = 0.f;
#pragma unroll
        for (int k = 0; k < 34; ++k) h = sv[k][0] * h + sv[k][1];
        cin[dir * 128 + chl] = h; }
    __syncthreads();
    float cf[8], cb[8];
#pragma unroll
    for (int i = 0; i < 8; ++i) { cf[i] = cin[c8 + i]; cb[i] = cin[128 + c8 + i]; }
#pragma unroll
    for (int j = 0; j < 4; ++j) { const int tt = (tid + NTHR * j) >> 4;
        const size_t off = (size_t)(row0 + tt) * D + g * 128 + c8;
        float u[8], pf[8], pb[8], gg[8]; unpack8(ru[j], u); unpack8(rpf[j], pf); unpack8(rpb[j], pb); unpack8(rgt[j], gg);
#pragma unroll
        for (int i = 0; i < 8; ++i) u[i] = (u[i] + pf[i] * cf[i] + pb[i] * cb[i]) * siluf_(gg[i]);
        u32x4 w; w.x = pk_bf16(u[0], u[1]); w.y = pk_bf16(u[2], u[3]); w.z = pk_bf16(u[4], u[5]); w.w = pk_bf16(u[6], u[7]);
        *(GAS u32x4*)(ain + off) = w; }
    __syncthreads();
}

constexpr int SG_STAT = 0;
constexpr int SG_VN = 2048;
__device__ __forceinline__ void sgu_item(const DP& p, unsigned char* smem, int l, int bl, int chunk) {
    const int tid = opq_v(threadIdx.x), lane = tid & 63, r32 = lane & 31, hi = lane >> 5; const int wid = __builtin_amdgcn_readfirstlane(tid >> 6);
    LAS unsigned char* lds3 = (LAS unsigned char*)smem;
    const GAS bf16_t* z = (const GAS bf16_t*)(p.ws + WS_Z);
    GAS bf16_t* cin = (GAS bf16_t*)(p.ws + WS_AIN) + (size_t)2 * RG * D;
    const int row0 = bl * RB + (chunk < 2 ? chunk * 128 : CL + (chunk - 2) * 128);
    float* stat = (float*)(smem + SG_STAT);
#pragma unroll
    for (int hb = 0; hb < 2; ++hb) {
        u32x4 ra[8], rb[8];
#pragma unroll
        for (int i = 0; i < 8; ++i) { const GAS bf16_t* vr = z + (size_t)(row0 + wid * 16 + hb * 8 + i) * DIN + ZC_CV; ra[i] = *(const GAS u32x4*)(vr + lane * 8); rb[i] = *(const GAS u32x4*)(vr + 512 + lane * 8); }
        float s1[8], s2[8];
#pragma unroll
        for (int i = 0; i < 8; ++i) { float a[8], b[8]; unpack8(ra[i], a); unpack8(rb[i], b); float t1 = 0.f, t2 = 0.f;
#pragma unroll
            for (int k = 0; k < 8; ++k) { t1 += a[k] + b[k]; t2 += a[k] * a[k] + b[k] * b[k]; }
            s1[i] = t1; s2[i] = t2; }
#pragma unroll
        for (int o = 1; o < 64; o <<= 1)
#pragma unroll
            for (int i = 0; i < 8; ++i) { s1[i] += __shfl_xor(s1[i], o); s2[i] += __shfl_xor(s2[i], o); }
        if (lane < 8) { float m1 = 0.f, m2 = 0.f;
#pragma unroll
            for (int i = 0; i < 8; ++i) if (lane == i) { m1 = s1[i]; m2 = s2[i]; }
            const float mean = m1 * (1.f / D); const float var = fmaxf(m2 * (1.f / D) - mean * mean, 0.f);
            const int tk = wid * 16 + hb * 8 + lane; stat[tk * 2] = mean; stat[tk * 2 + 1] = 1.f / sqrtf(var + 1e-5f); }
    }
    __syncthreads();
    const int pblk = wid & 3, cb0 = (wid >> 2) * 2;
    const unsigned laneaddr = ((lane >> 4) & 1) * 32 + (lane & 3) * 8 + (4 * hi + ((lane & 15) >> 2)) * 64;
    for (int g = 0; g < 8; ++g) {
        unsigned char* vn = smem + SG_VN + (g & 1) * 32768;
        { const int c8 = (tid & 15) * 8; float lg[8], lb[8];
          const GAS float* lgp = p.in[I_SLG] + l * D + g * 128 + c8; const GAS float* lbp = p.in[I_SLB] + l * D + g * 128 + c8;
          const f32x4 g0 = *(const GAS f32x4*)lgp, g1 = *(const GAS f32x4*)(lgp + 4), b0 = *(const GAS f32x4*)lbp, b1 = *(const GAS f32x4*)(lbp + 4);
#pragma unroll
          for (int i = 0; i < 4; ++i) { lg[i] = g0[i]; lg[4 + i] = g1[i]; lb[i] = b0[i]; lb[4 + i] = b1[i]; }
          u32x4 rv[4];
#pragma unroll
          for (int j = 0; j < 4; ++j) { const int qq = (tid + NTHR * j) >> 4; rv[j] = *(const GAS u32x4*)(z + (size_t)(row0 + qq) * DIN + ZC_CV + g * 128 + c8); }
#pragma unroll
          for (int j = 0; j < 4; ++j) { const int qq = (tid + NTHR * j) >> 4; float v[8]; unpack8(rv[j], v);
              const float mean = stat[qq * 2], rstd = stat[qq * 2 + 1];
#pragma unroll
              for (int i = 0; i < 8; ++i) v[i] = (v[i] - mean) * rstd * lg[i] + lb[i];
              u32x4 w; w.x = pk_bf16(v[0], v[1]); w.y = pk_bf16(v[2], v[3]); w.z = pk_bf16(v[4], v[5]); w.w = pk_bf16(v[6], v[7]);
              *(u32x4*)(vn + ((c8 >> 5) * 8 + (qq >> 4)) * 1024 + (qq & 15) * 64 + (c8 & 31) * 2) = w; } }
        const GAS bf16_t* wp = (const GAS bf16_t*)(p.ws + WS_SGUW) + (size_t)(l * 8 + g) * 16384 + (size_t)(32 * pblk + r32) * 128 + 4 * hi;
        u32x2 wlo[8], whi[8];
#pragma unroll
        for (int ks = 0; ks < 8; ++ks) { wlo[ks] = *(const GAS u32x2*)(wp + 16 * ks); whi[ks] = *(const GAS u32x2*)(wp + 16 * ks + 8); }
        __syncthreads();
        f32x16 acc[2]; acc[0] = f32x16{}; acc[1] = f32x16{};
        LAS const unsigned char* vb = lds3 + SG_VN + (g & 1) * 32768 + laneaddr;
#pragma unroll
        for (int ks = 0; ks < 8; ++ks) { const u32x4 aw = (u32x4){wlo[ks][0], wlo[ks][1], whi[ks][0], whi[ks][1]};
#pragma unroll
            for (int cb = 0; cb < 2; ++cb) { const s16x4 lo = vtr(vb + ((cb0 + cb) * 8 + ks) * 1024), hh = vtr(vb + ((cb0 + cb) * 8 + ks) * 1024 + 512);
                acc[cb] = __builtin_amdgcn_mfma_f32_32x32x16_bf16(__builtin_bit_cast(bf16x8, aw), (bf16x8){lo[0], lo[1], lo[2], lo[3], hh[0], hh[1], hh[2], hh[3]}, acc[cb], 0, 0, 0); } }
        const GAS float* bsp = p.in[I_SB] + (size_t)(l * 8 + g) * 128 + 32 * pblk;
#pragma unroll
        for (int r = 0; r < 16; ++r) { const int pp = crow(r, hi); const float bs = bsp[pp]; const size_t grow = (size_t)(row0 + 32 * pblk + pp);
#pragma unroll
            for (int cb = 0; cb < 2; ++cb) { const int col = g * 128 + 32 * (cb0 + cb) + r32;
                const float u = bf1(z[grow * DIN + ZC_CU + col]), gate = bf1(z[grow * DIN + ZC_CG + col]);
                cin[grow * D + col] = f2bf(u * (acc[cb][r] + bs) * siluf_(gate)); } }
    }
    __syncthreads();
}

__device__ __forceinline__ void phase_mixers(const DP& p, unsigned char* smem, int grp, int l, int rep = 0) {
    const int tid = threadIdx.x;
    GAS unsigned* ctr = (GAS unsigned*)(p.ws + WS_CTL) + (grp * NL + l) * 64 + rep * 32;
    volatile int* sh = (volatile int*)(smem + LDS_IDX_OFF);
    const int nq = (l == 0) ? 17 : 16, nch = (l == 0) ? 34 : 32;
    const int n_att = GB * 8 * nq, n_lru = GB * 8 * 34, n_sgu = GB * nch, total = n_lru + n_att + n_sgu;
    for (;;) {
        __syncthreads();
        if (tid == 0) *sh = (int)atomicAdd((unsigned*)ctr, 1u);
        __syncthreads();
        const int idx = *sh;
        if (idx >= total) break;
        if (idx < n_sgu) { const int cc = idx; int chn, bl; if (l == 0) { chn = cc % 34; bl = cc / 34; } else { chn = cc & 31; bl = cc >> 5; } sgu_item(p, smem, l, bl, (l == 0) ? chn : chn + 2); }
        else if (idx < n_sgu + n_att) { const int a = idx - n_sgu; int qi, bh; if (l == 0) { qi = a % 17; bh = a / 17; } else { qi = a & 15; bh = a >> 4; } attn_unit(p, smem, l, bh >> 3, bh & 7, (l == 0) ? qi : qi + 1); }
        else { const int a = idx - n_att - n_sgu; const int g = a & 7, cc = a >> 3; lru_s1_item(p, smem, l, cc / 34, g, cc % 34); }
    }
}
__device__ __forceinline__ void phase_combine(const DP& p, unsigned char* smem) {
    for (int it = blockIdx.x; it < GB * 34 * 8; it += gridDim.x) { const int g = it & 7, cc = it >> 3; lru_combine_item(p, smem, cc / 34, cc % 34, g); }
}

#define XB_TMO      128
#define XB_XCNT(j)  (256  + 64 * (j))
#define XB_XSUB(j)  (1280 + 64 * (j))
#define XB_XGEN(j)  (2304 + 64 * (j))
#define XB_TOP      3328
#define XB_TOPGEN   3392
#define XCD_BAR_WORDS 3456
#define XB_SPIN_CAP (1u << 22)
__device__ __forceinline__ unsigned xb_ld(unsigned* p)              { return __hip_atomic_load(p, __ATOMIC_RELAXED, __HIP_MEMORY_SCOPE_AGENT); }
__device__ __forceinline__ unsigned xb_add(unsigned* p, unsigned v) { return __hip_atomic_fetch_add(p, v, __ATOMIC_RELAXED, __HIP_MEMORY_SCOPE_AGENT); }
__device__ __forceinline__ unsigned xb_xcc_id() { return (unsigned)__builtin_amdgcn_s_getreg((3 << 11) | 20) & 0xFu; }
#define XB_SPIN(cond, bar) do { unsigned _sp = 0; while (cond) { __builtin_amdgcn_s_sleep(1); \
    if ((++_sp & 255u) == 0u) { if (xb_ld(&(bar)[XB_TMO])) break; if (_sp > XB_SPIN_CAP) { atomicAdd(&(bar)[XB_TMO], 1u); break; } } } } while (0)
struct XcdBarrier { unsigned* bar; unsigned x; volatile LAS unsigned* st; };
__device__ __forceinline__ XcdBarrier xcd_barrier_post(unsigned* bar, volatile LAS unsigned* st) {
    XcdBarrier b; b.bar = bar; b.x = xb_xcc_id(); b.st = st;
    if (threadIdx.x == 0) (void)xb_add(&bar[XB_XCNT(b.x)], 1u);
    return b;
}
__device__ __forceinline__ void xcd_barrier_complete(unsigned* bar, unsigned x, unsigned& nloc, unsigned& nx) {
    const unsigned G = gridDim.x * gridDim.y * gridDim.z;
    unsigned sum, cnt, mine, sp = 0u;
    for (;;) {
        sum = 0u; cnt = 0u; mine = 0u;
#pragma unroll
        for (unsigned j = 0; j < 16; ++j) { const unsigned c = xb_ld(&bar[XB_XCNT(j)]); sum += c; cnt += (c > 0u) ? 1u : 0u; mine = (j == x) ? c : mine; }
        if (sum == G) break;
        __builtin_amdgcn_s_sleep(1);
        if ((++sp & 255u) == 0u) { if (xb_ld(&bar[XB_TMO])) break; if (sp > XB_SPIN_CAP) { atomicAdd(&bar[XB_TMO], 1u); break; } }
    }
    nloc = mine > 0u ? mine : 1u; nx = cnt > 0u ? cnt : 1u;
}
__device__ __forceinline__ void xcd_barrier(const XcdBarrier& b) {
    asm volatile("s_waitcnt vmcnt(0)" ::: "memory");
    __syncthreads();
    if (threadIdx.x == 0) {
        unsigned* bar = b.bar;
        __builtin_amdgcn_s_waitcnt(0);
        unsigned nloc = b.st[0], nx = b.st[1];
        if (nloc == 0u) { xcd_barrier_complete(bar, b.x, nloc, nx); b.st[0] = nloc; b.st[1] = nx; }
        const unsigned old = xb_add(&bar[XB_XSUB(b.x)], 1u);
        const unsigned gen = old / nloc;
        if (old + 1u == (gen + 1u) * nloc) {
            __builtin_amdgcn_fence(__ATOMIC_RELEASE, "agent");
            asm volatile("s_waitcnt vmcnt(0)" ::: "memory");
            const unsigned og = xb_add(&bar[XB_TOP], 1u);
            const unsigned tg = og / nx;
            if (og + 1u == (tg + 1u) * nx) xb_add(&bar[XB_TOPGEN], 1u);
            else XB_SPIN(xb_ld(&bar[XB_TOPGEN]) == tg, bar);
            __builtin_amdgcn_fence(__ATOMIC_ACQUIRE, "agent");
            xb_add(&bar[XB_XGEN(b.x)], 1u);
            asm volatile("s_waitcnt vmcnt(0)" ::: "memory");
        } else {
            XB_SPIN(xb_ld(&bar[XB_XGEN(b.x)]) == gen, bar);
            __builtin_amdgcn_fence(__ATOMIC_ACQUIRE, "agent");
            asm volatile("s_waitcnt vmcnt(0)" ::: "memory");
        }
    }
    __syncthreads();
}

struct EpiOutLN {
    static constexpr bool PERM = true;
    const GAS float* srcX; GAS float* dstX; const GAS float* mod; const GAS float* lng; const GAS float* lnb; GAS f32x2* stats; unsigned char* smem; unsigned* bar; int grp;
    GAS bf16_t* xm; const GAS float* mod1;
    __device__ __forceinline__ void operator()(f32x4 (&acc)[2][2][4][2], const pg8::Unit& u, int wr, int wc, int fr, int fq) const {
        using namespace pg8;
        const int bl = u.rm / TILES_B, tt = u.rm % TILES_B, b = grp * GB + bl;
        const int col0 = u.rn * BM + wc * 32 + 8 * fq;
        f32x2* P = (f32x2*)(smem + 131072);
        f32x2* S = (f32x2*)(smem + 131072 + 8192);
        { const GAS float* gt = mod + (size_t)b * 3072 + 2048 + col0;
#pragma unroll
          for (int ai = 0; ai < 2; ++ai)
#pragma unroll
            for (int m = 0; m < 4; ++m) {
                const int rit = ai * HALF + wr * 64 + m * 16 + fr;
                const GAS float* sp = srcX + ((size_t)b * T + (tt - 1) * 256 + rit) * D + col0;
                float sm = 0.f, sq = 0.f;
#pragma unroll
                for (int bj = 0; bj < 2; ++bj)
#pragma unroll
                    for (int n = 0; n < 2; ++n) { const f32x4 xr = *(const GAS f32x4*)(sp + bj * HALF + 4 * n); const f32x4 gv = *(const GAS f32x4*)(gt + bj * HALF + 4 * n);
                        const f32x4 v = xr * ALPHA + gv * acc[ai][bj][m][n]; acc[ai][bj][m][n] = v;
                        sm += (v[0] + v[1]) + (v[2] + v[3]); sq += (v[0] * v[0] + v[1] * v[1]) + (v[2] * v[2] + v[3] * v[3]); }
                sm += __shfl_xor(sm, 16); sm += __shfl_xor(sm, 32); sq += __shfl_xor(sq, 16); sq += __shfl_xor(sq, 32);
                if (fq == 0) P[rit * 4 + wc] = (f32x2){sm, sq};
            } }
        __syncthreads();
        const int tid = threadIdx.x;
        if (tid < 256) { const f32x2 a = P[tid * 4], b2 = P[tid * 4 + 1], c = P[tid * 4 + 2], d = P[tid * 4 + 3];
            stats[(size_t)(u.rm * BM + tid) * 4 + u.rn] = (f32x2){(a[0] + b2[0]) + (c[0] + d[0]), (a[1] + b2[1]) + (c[1] + d[1])}; }
        { XcdBarrier xb_; xb_.bar = bar; xb_.x = xb_xcc_id(); xb_.st = (volatile LAS unsigned*)((LAS unsigned char*)smem + LDS_IDX_OFF + 16); xcd_barrier(xb_); }
        if (tid < 256) { const GAS f32x2* sp = stats + (size_t)(u.rm * BM + tid) * 4; const f32x2 a = sp[0], b2 = sp[1], c = sp[2], d = sp[3];
            const float mean = ((a[0] + b2[0]) + (c[0] + d[0])) * (1.f / D); const float var = fmaxf(((a[1] + b2[1]) + (c[1] + d[1])) * (1.f / D) - mean * mean, 0.f);
            S[tid] = (f32x2){mean, 1.f / sqrtf(var + 1e-5f)}; }
        __syncthreads();
        f32x4 g4[2][2], b4[2][2];
#pragma unroll
        for (int bj = 0; bj < 2; ++bj)
#pragma unroll
            for (int n = 0; n < 2; ++n) { g4[bj][n] = *(const GAS f32x4*)(lng + col0 + bj * HALF + 4 * n); b4[bj][n] = *(const GAS f32x4*)(lnb + col0 + bj * HALF + 4 * n); }
#pragma unroll
        for (int ai = 0; ai < 2; ++ai)
#pragma unroll
            for (int m = 0; m < 4; ++m) {
                const int rit = ai * HALF + wr * 64 + m * 16 + fr; const f32x2 ms = S[rit];
                GAS float* dp = dstX + ((size_t)b * T + (tt - 1) * 256 + rit) * D + col0;
#pragma unroll
                for (int bj = 0; bj < 2; ++bj) {
                    const f32x4 o0 = (acc[ai][bj][m][0] - ms[0]) * ms[1] * g4[bj][0] + b4[bj][0], o1 = (acc[ai][bj][m][1] - ms[0]) * ms[1] * g4[bj][1] + b4[bj][1];
                    *(GAS f32x4*)(dp + bj * HALF) = o0; *(GAS f32x4*)(dp + bj * HALF + 4) = o1;
                    if (xm) { const GAS float* md = mod1 + (size_t)b * 3072 + col0 + bj * HALF;
                        const f32x4 sh0 = *(const GAS f32x4*)md, sh1 = *(const GAS f32x4*)(md + 4), sc0 = *(const GAS f32x4*)(md + 1024), sc1 = *(const GAS f32x4*)(md + 1028);
                        const f32x4 r0 = o0 * (sc0 + 1.f) + sh0, r1 = o1 * (sc1 + 1.f) + sh1;
                        u32x4 w; w.x = pk_bf16(r0[0], r0[1]); w.y = pk_bf16(r0[2], r0[3]); w.z = pk_bf16(r1[0], r1[1]); w.w = pk_bf16(r1[2], r1[3]);
                        *(GAS u32x4*)(xm + (size_t)(u.rm * BM + rit) * D + col0 + bj * HALF) = w; } }
            }
    }
};
struct SchedCtx { int G, c;
    __device__ bool next(int i, pg8::Unit& u) const { const int ti = i * G + c; if (ti >= GB * 4) return false;
        u.rm = (ti >> 2) * TILES_B; u.rn = ti & 3; u.br = 0; u.xb = -1; u.pm = u.rm; u.pn = u.rn; return true; } };

__global__ void __launch_bounds__(NTHR, 2) fwd_megakernel(Params p) {
    extern __shared__ __attribute__((aligned(16))) unsigned char smem[];
    cg::grid_group grid = cg::this_grid();
    if (threadIdx.x < 2) ((volatile LAS unsigned*)((LAS unsigned char*)smem + LDS_IDX_OFF + 16))[threadIdx.x] = 0u;
    __syncthreads();
    (void)xcd_barrier_post((unsigned*)(p.ws + WS_CTL + 16384), (volatile LAS unsigned*)((LAS unsigned char*)smem + LDS_IDX_OFF + 16));
#define GRID_BAR() do { XcdBarrier xb_; xb_.bar = (unsigned*)(opq_p(p.ws) + WS_CTL + 16384); xb_.x = xb_xcc_id(); xb_.st = (volatile LAS unsigned*)((LAS unsigned char*)smem + LDS_IDX_OFF + 16); xcd_barrier(xb_); } while (0)
    LAS unsigned char* lds3 = (LAS unsigned char*)smem;
#define MAKE_DP(q) DP q; _Pragma("unroll") for (int i_ = 0; i_ < 25; ++i_) q.in[i_] = (const GAS float*)p.in[i_]; q.out = opq_p((GAS float*)p.out); q.ws = opq_p((GAS unsigned char*)p.ws)
    { MAKE_DP(q); phase_prologue(q, smem); }
    grid.sync();
    { MAKE_DP(q); phase_xm0(q, 0); }
    GRID_BAR();
    for (int grp = 0; grp < NGRP; ++grp) {
        for (int l = 0; l < NL; ++l) {
            const bool last = (l == NL - 1);
            { MAKE_DP(d); GAS unsigned char* ws = d.ws; const int G = opq_s(gridDim.x), c = opq_s(blockIdx.x);
              pg8::Gemm g{(const GAS bf16_t*)(ws + WS_XM), (const GAS bf16_t*)(ws + WS_WIN) + (size_t)l * DIN * D, D};
              pg8::SchedGrid S; S.init(TILES_G, DIN / 256, G, c);
              pg8::EpiInProj E{(GAS bf16_t*)(ws + WS_Z), d.in[I_BIN] + l * DIN, (const GAS float*)(ws + WS_ROPE), (GAS bf16_t*)(ws + WS_KC), (GAS bf16_t*)(ws + WS_VC)};
              pg8::gemm_phase<pg8::EpiInProj, pg8::SchedGrid, false, true>(lds3, g, S, E); }
            GRID_BAR();
            { MAKE_DP(q); phase_mixers(q, smem, opq_s(grp), opq_s(l)); }
            GRID_BAR();
            { MAKE_DP(q); phase_combine(q, smem); }
            GRID_BAR();
            { MAKE_DP(d); GAS unsigned char* ws = d.ws; const int G = opq_s(gridDim.x), c = opq_s(blockIdx.x);
              pg8::Gemm g{(const GAS bf16_t*)(ws + WS_AIN), (const GAS bf16_t*)(ws + WS_WBR) + (size_t)l * 3 * D * D, D};
              pg8::SchedRows<3> S; S.init(true, G, c, !last);
              pg8::EpiMerge E{(const GAS bf16_t*)(ws + WS_Z), (GAS bf16_t*)(ws + WS_MB), (GAS float*)(ws + WS_PART)};
              pg8::gemm_phase<pg8::EpiMerge, pg8::SchedRows<3>>(lds3, g, S, E); }
            GRID_BAR();
            if (!last) { MAKE_DP(d);
              for (int gid = (int)blockIdx.x * NTHR + opq_v(threadIdx.x); gid < GB * CL * (D / 8); gid += (int)gridDim.x * NTHR) { const int r = gid >> 7, c8 = (gid & 127) * 8; const GAS float* pp = (const GAS float*)(d.ws + WS_PART) + (size_t)r * D + c8; const size_t bs = (size_t)GB * CL * D;
                  const f32x4 a0 = *(const GAS f32x4*)pp, a1 = *(const GAS f32x4*)(pp + 4), b0 = *(const GAS f32x4*)(pp + bs), b1 = *(const GAS f32x4*)(pp + bs + 4), c0 = *(const GAS f32x4*)(pp + 2 * bs), c1 = *(const GAS f32x4*)(pp + 2 * bs + 4);
                  const f32x4 s0 = (a0 + b0) + c0, s1 = (a1 + b1) + c1; u32x4 w; w.x = pk_bf16(s0[0], s0[1]); w.y = pk_bf16(s0[2], s0[3]); w.z = pk_bf16(s1[0], s1[1]); w.w = pk_bf16(s1[2], s1[3]);
                  *(GAS u32x4*)((GAS bf16_t*)(d.ws + WS_MB) + ((size_t)(r >> 8) * RB + (r & 255)) * D + c8) = w; } }
            { MAKE_DP(d); GAS unsigned char* ws = d.ws; const int G = opq_s(gridDim.x), c = opq_s(blockIdx.x); GAS float* outp = d.out;
              pg8::Gemm g{(const GAS bf16_t*)(ws + WS_MB), (const GAS bf16_t*)(ws + WS_WOUT) + (size_t)l * D * D, D};
              pg8::SchedRows<1> S; S.init(true, G, c);
              EpiOutLN E{l == 0 ? d.in[I_X] : (const GAS float*)outp, outp, (const GAS float*)(ws + WS_MOD) + (size_t)l * 17 * 3072, d.in[I_LNG] + l * D, d.in[I_LNB] + l * D, (GAS f32x2*)(ws + WS_STATS), smem, (unsigned*)(ws + WS_CTL + 16384), grp,
                         last ? (GAS bf16_t*)nullptr : (GAS bf16_t*)(ws + WS_XM), (const GAS float*)(ws + WS_MOD) + (size_t)(l + 1) * 17 * 3072};
              pg8::gemm_phase<EpiOutLN, pg8::SchedRows<1>>(lds3, g, S, E); }
            if (!last) {
              { MAKE_DP(d); GAS unsigned char* ws = d.ws; const int G = opq_s(gridDim.x), c = opq_s(blockIdx.x);
                pg8::Gemm g{(const GAS bf16_t*)(ws + WS_MB), (const GAS bf16_t*)(ws + WS_WOUT) + (size_t)l * D * D, D};
                SchedCtx S{G, c};
                pg8::EpiOut E{d.in[I_X], l == 0 ? d.in[I_CTX] : (const GAS float*)(ws + WS_CTX1), d.out, (GAS float*)(ws + WS_CTX1), (const GAS float*)(ws + WS_MOD) + (size_t)l * 17 * 3072, grp};
                pg8::gemm_phase<pg8::EpiOut, SchedCtx>(lds3, g, S, E); }
              GRID_BAR();
              { MAKE_DP(q); phase_ln(q, opq_s(grp), opq_s(l), true); }
            }
            if (l == NL - 1 && grp + 1 < NGRP) { MAKE_DP(q); phase_xm0(q, opq_s(grp + 1)); }
            if (!(l == NL - 1 && grp + 1 == NGRP)) GRID_BAR();
        }
    }
}

extern "C" void kernel_launch(void* const* d_in, const int* in_sizes, int n_in, void* d_out, int out_size, void* d_ws, size_t ws_size, hipStream_t stream) {
    static int grid = 0;
    if (grid == 0) {
        if (n_in != 25 || ws_size < WS_END) { fprintf(stderr, "kernel_launch: unexpected n_in %d / ws_size %zu\n", n_in, ws_size); grid = -1; return; }
        int dev = 0, cus = 0, per_cu = 0;
        hipGetDevice(&dev);
        hipDeviceGetAttribute(&cus, hipDeviceAttributeMultiprocessorCount, dev);
        hipFuncSetAttribute((const void*)fwd_megakernel, hipFuncAttributeMaxDynamicSharedMemorySize, LDS_BYTES);
        hipOccupancyMaxActiveBlocksPerMultiprocessor(&per_cu, (const void*)fwd_megakernel, NTHR, LDS_BYTES);
        if (per_cu < 1) { fprintf(stderr, "kernel_launch: occupancy query says %d blocks per CU\n", per_cu); per_cu = 1; }
        (void)hipGetLastError();
        grid = cus;
    }
    if (grid < 0) return;
    hipMemsetAsync((char*)d_ws + WS_CTL, 0, CTL_BYTES, stream);
    Params p{};
    for (int i = 0; i < 25; ++i) p.in[i] = (const float*)d_in[i];
    p.out = (float*)d_out; p.ws = (unsigned char*)d_ws;
    void* args[] = {&p};
    hipError_t e = hipLaunchCooperativeKernel((const void*)fwd_megakernel, dim3(grid), dim3(NTHR), args, LDS_BYTES, stream);
    if (e != hipSuccess) fprintf(stderr, "cooperative launch failed: %s (grid %d)\n", hipGetErrorString(e), grid);
}
```

```cpp
#include <hip/hip_runtime.h>
#include <hip/hip_cooperative_groups.h>
#include <cstdint>
#include <cstdio>
namespace cg = cooperative_groups;

#define LAS __attribute__((address_space(3)))
#define GAS __attribute__((address_space(1)))
typedef unsigned short bf16_t;
typedef short bf16x8 __attribute__((ext_vector_type(8)));
typedef short s16x4 __attribute__((ext_vector_type(4)));
typedef float f32x2 __attribute__((ext_vector_type(2)));
typedef float f32x4 __attribute__((ext_vector_type(4)));
typedef float f32x16 __attribute__((ext_vector_type(16)));
typedef unsigned u32x4 __attribute__((ext_vector_type(4)));
typedef unsigned u32x2 __attribute__((ext_vector_type(2)));
typedef __bf16 bf16x2_t __attribute__((ext_vector_type(2)));

constexpr int D = 1024, NB = 16, T = 4096, CL = 256, NL = 2, DIN = 12288;
constexpr int GB = 4, NGRP = NB / GB;
constexpr int RB = CL + T;
constexpr int RG = GB * RB;
constexpr int TILES_B = RB / 256;
constexpr int TILES_G = RG / 256;
constexpr float ALPHA = 1.41421356237f;
constexpr float C2 = 0.125f * 1.4426950408889634f;
constexpr int NWAVES = 8, NTHR = 512;
constexpr int LDS_BYTES = 147456;
constexpr int LDS_IDX_OFF = 147456 - 64;

constexpr int ZC_AX = 0, ZC_AG = 1024, ZC_Q = 2048, ZC_K = 3072, ZC_V = 4096, ZC_BG = 5120, ZC_CU = 6144, ZC_CV = 7168, ZC_CG = 8192, ZC_MG = 9216;

constexpr size_t MiB = 1u << 20;
constexpr size_t WS_CTL = 0, CTL_BYTES = 65536;
constexpr size_t WS_MOD = 1 * MiB;
constexpr size_t WS_ROPE = 1 * MiB + 512 * 1024;
constexpr size_t WS_SCAL = WS_ROPE + 16384;
constexpr size_t WS_WIN = 2 * MiB;
constexpr size_t WS_WBR = 50 * MiB;
constexpr size_t WS_WOUT = 62 * MiB;
constexpr size_t WS_LRUW = 66 * MiB;
constexpr size_t WS_SGUW = 68 * MiB;
constexpr size_t WS_CTX1 = 70 * MiB;
constexpr size_t WS_XM = 86 * MiB;
constexpr size_t WS_Z = 122 * MiB;
constexpr size_t WS_AIN = 530 * MiB;
constexpr size_t WS_MB = 632 * MiB;
constexpr size_t WS_PB = 666 * MiB;
constexpr size_t WS_SUM = 700 * MiB;
constexpr size_t WS_KC = 704 * MiB;
constexpr size_t WS_VC = 738 * MiB;
constexpr size_t WS_PART = 772 * MiB;
constexpr size_t WS_STATS = 784 * MiB;
constexpr size_t WS_END = 785 * MiB;

__device__ __forceinline__ unsigned pk_bf16(float lo, float hi) { f32x2 v = {lo, hi}; bf16x2_t b = __builtin_convertvector(v, bf16x2_t); return __builtin_bit_cast(unsigned, b); }
__device__ __forceinline__ float bflo(unsigned w) { return __uint_as_float(w << 16); }
__device__ __forceinline__ float bfhi(unsigned w) { return __uint_as_float(w & 0xffff0000u); }
__device__ __forceinline__ float bf1(bf16_t h) { return __uint_as_float((unsigned)h << 16); }
__device__ __forceinline__ bf16_t f2bf(float f) { return (bf16_t)(pk_bf16(f, 0.f) & 0xffffu); }
__device__ __forceinline__ void unpack8(const u32x4 w, float* f) { f[0] = bflo(w.x); f[1] = bfhi(w.x); f[2] = bflo(w.y); f[3] = bfhi(w.y); f[4] = bflo(w.z); f[5] = bfhi(w.z); f[6] = bflo(w.w); f[7] = bfhi(w.w); }
__device__ __forceinline__ float sigmoidf_(float x) { return __builtin_amdgcn_rcpf(1.f + __expf(-x)); }
__device__ __forceinline__ float siluf_(float x) { return x * sigmoidf_(x); }
__device__ __forceinline__ float wave_sum(float v) {
#pragma unroll
    for (int o = 1; o < 64; o <<= 1) v += __shfl_xor(v, o);
    return v;
}
#define LDS_WAIT() asm volatile("s_waitcnt lgkmcnt(0)" ::: "memory")
__device__ __forceinline__ int opq_v(int v) { asm volatile("" : "+v"(v)); return v; }
__device__ __forceinline__ int opq_s(int v) { asm volatile("" : "+s"(v)); return v; }
template <class Tp> __device__ __forceinline__ Tp* opq_p(Tp* p) { asm volatile("" : "+s"(p)); return p; }

namespace pg8 {
constexpr int BM = 256, BK = 64, HALF = 128, HTB = HALF * BK * 2, STAGE_BYTES = 8 * HTB, NXCD = 8, WGM = 4;
__host__ __device__ __forceinline__ int lds_byte(int r, int c) { const int st = (r >> 4) * 2 + (c >> 5), rr = r & 15, cc = c & 31, ob = rr * 64 + cc * 2; return st * 1024 + (ob ^ (((ob >> 9) & 1) << 5)); }
__host__ __device__ __forceinline__ void stage_rc(int b, int& R, int& C) { const int st = b / 1024, sb = b % 1024, swz = sb ^ (((sb >> 9) & 1) << 5); R = (st >> 1) * 16 + swz / 64; C = (st & 1) * 32 + (swz % 64) / 2; }
__host__ __device__ __forceinline__ int perm32(int rho) { const int n = rho >> 4, i = rho & 15; return 8 * (i >> 2) + 4 * n + (i & 3); }

struct Unit { int pm, pn, rm, rn, br, xb; };
struct Gemm { const GAS bf16_t* A; const GAS bf16_t* Bt; int K; };

struct SchedGrid {
    int nM, nN, nwg, G, c;
    __device__ void init(int nM_, int nN_, int G_, int c_) { nM = nM_; nN = nN_; nwg = nM * nN; G = G_; c = c_; }
    __device__ bool next(int i, Unit& u) const {
        const long L = (long)i * G + c; if (L >= nwg) return false;
        int wgid = (int)L; { const int q = nwg / NXCD, r = nwg % NXCD, xcd = wgid % NXCD, off = wgid / NXCD; wgid = (xcd < r ? xcd * (q + 1) : r * (q + 1) + (xcd - r) * q) + off; }
        const int nig = WGM * nN, gid = wgid / nig, fm = gid * WGM, gsz = (nM - fm) < WGM ? (nM - fm) : WGM;
        u.pm = fm + ((wgid % nig) % gsz); u.pn = (wgid % nig) / gsz; u.rm = u.pm; u.rn = u.pn; u.br = 0; u.xb = -1; return true;
    }
};
template <int NBR> struct SchedRows {
    int nrow, G, c; bool skip_ctx, extra;
    __device__ void init(bool skip, int G_, int c_, bool extra_ = false) { skip_ctx = skip; nrow = skip ? GB * 16 : TILES_G; G = G_; c = c_; extra = extra_; }
    __device__ bool next(int i, Unit& u) const {
        const int ti = (i / NBR) * G + c;
        if (ti >= nrow * 4) {
            if (!extra) return false;
            const int ntile = nrow * 4, mine = (c < ntile) ? (ntile - c + G - 1) / G : 0;
            const int x = (i - NBR * mine) * G + c; if (x < 0 || x >= GB * 4 * 3) return false;
            const int et = x / 3, xbr = x % 3, pmc = (et >> 2) * TILES_B, pnc = et & 3;
            u.rm = pmc; u.rn = pnc; u.br = 0; u.xb = xbr; u.pm = xbr * TILES_G + pmc; u.pn = xbr * 4 + pnc; return true;
        }
        const int br = i % NBR, pn = ti & 3, j = ti >> 2;
        const int pm = skip_ctx ? ((j >> 4) * TILES_B + 1 + (j & 15)) : j;
        u.rm = pm; u.rn = pn; u.br = br; u.xb = -1; u.pm = br * TILES_G + pm; u.pn = br * 4 + pn; return true;
    }
};

template <class Epi, class Sched, bool ALIGN_EPI = true, bool SP2 = true>
__device__ __forceinline__ void gemm_phase(LAS unsigned char* lds, const Gemm g, const Sched& S, const Epi& E) {
    const int tid = opq_v(threadIdx.x), wid = __builtin_amdgcn_readfirstlane(tid >> 6), lane = tid & 63, wr = wid >> 2, wc = wid & 3, fr = lane & 15, fq = lane >> 4;
    const int K = g.K, nt = K / BK;
    unsigned voffA[2], voffB[2];
#pragma unroll
    for (int i = 0; i < 2; ++i) { int R, C; stage_rc(tid * 16 + i * 8192, R, C); const int Rb = Epi::PERM ? ((R & ~31) + perm32(R & 31)) : R;
        voffA[i] = (unsigned)(R * K + C) * 2u; voffB[i] = (unsigned)(Rb * K + C) * 2u; }
    const size_t kstep = (size_t)(BK * 2);
    const size_t hstep = (size_t)HALF * K * 2;
    const size_t tstep = 2 * hstep;
    const unsigned ldsw = (unsigned)wid * 1024u;
    const int aoff = lds_byte(wr * 64 + fr, fq * 8), boff = lds_byte(wc * 32 + fr, fq * 8);
#define PG8_SA(b, h) (((b) * 2 + (h)) * HTB)
#define PG8_SB(b, h) ((4 + (b) * 2 + (h)) * HTB)
#define PG8_STAGE(bufoff, gbase, voff) do { _Pragma("unroll") for (int _i = 0; _i < 2; ++_i) \
        __builtin_amdgcn_global_load_lds((const GAS unsigned*)((const GAS char*)(gbase) + (voff)[_i]), (LAS unsigned*)(lds + (bufoff) + ldsw + _i * 8192), 16, 0, 0); } while (0)
#define PG8_LDA(dst, b, h) do { _Pragma("unroll") for (int m = 0; m < 4; ++m) _Pragma("unroll") for (int k = 0; k < 2; ++k) dst[m][k] = *(const LAS bf16x8*)(lds + PG8_SA(b, h) + aoff + m * 2048 + k * 1024); } while (0)
#define PG8_LDB(dst, b, h) do { _Pragma("unroll") for (int n = 0; n < 2; ++n) _Pragma("unroll") for (int k = 0; k < 2; ++k) dst[n][k] = *(const LAS bf16x8*)(lds + PG8_SB(b, h) + boff + n * 2048 + k * 1024); } while (0)
#define PG8_MMA(ai, bj, At, Bt) do { __builtin_amdgcn_s_setprio(1); _Pragma("unroll") for (int m = 0; m < 4; ++m) _Pragma("unroll") for (int n = 0; n < 2; ++n) _Pragma("unroll") for (int k = 0; k < 2; ++k) \
        acc[ai][bj][m][n] = __builtin_amdgcn_mfma_f32_16x16x32_bf16(Bt[n][k], At[m][k], acc[ai][bj][m][n], 0, 0, 0); __builtin_amdgcn_s_setprio(0); } while (0)
#define PG8_WAIT_V(n) asm volatile("s_waitcnt vmcnt(" #n ")" ::: "memory")
#define PG8_WAIT_L(n) asm volatile("s_waitcnt lgkmcnt(" #n ")" ::: "memory")
#define PG8_BAR __builtin_amdgcn_s_barrier()
#define PG8_SCHED __builtin_amdgcn_sched_barrier(0)
    Unit cur, nxt; int ui = 0;
    if (!S.next(0, cur)) return;
    f32x4 acc[2][2][4][2];
#pragma unroll
    for (int a = 0; a < 2; ++a)
#pragma unroll
        for (int b = 0; b < 2; ++b)
#pragma unroll
            for (int m = 0; m < 4; ++m)
#pragma unroll
                for (int n = 0; n < 2; ++n) acc[a][b][m][n] = (f32x4){0.f, 0.f, 0.f, 0.f};
    bf16x8 At[4][2], B0[2][2], B1[2][2];
    const GAS char* cA = (const GAS char*)g.A + (size_t)cur.pm * tstep; const GAS char* cB = (const GAS char*)g.Bt + (size_t)cur.pn * tstep;
    if constexpr (SP2) {
        PG8_STAGE(PG8_SB(0, 0), cB, voffB); PG8_STAGE(PG8_SB(0, 1), cB + hstep, voffB); PG8_STAGE(PG8_SA(0, 0), cA, voffA); PG8_STAGE(PG8_SA(0, 1), cA + hstep, voffA);
        if (wr == 1) PG8_BAR;
        PG8_WAIT_V(2); PG8_BAR;
        PG8_STAGE(PG8_SB(1, 0), cB + kstep, voffB); PG8_STAGE(PG8_SA(1, 0), cA + kstep, voffA); PG8_STAGE(PG8_SB(1, 1), cB + hstep + kstep, voffB);
        PG8_WAIT_V(6); PG8_BAR;
    } else {
        PG8_STAGE(PG8_SB(0, 0), cB, voffB); PG8_STAGE(PG8_SA(0, 0), cA, voffA); PG8_STAGE(PG8_SB(0, 1), cB + hstep, voffB); PG8_STAGE(PG8_SA(0, 1), cA + hstep, voffA);
        if (wr == 1) PG8_BAR;
        PG8_WAIT_V(4); PG8_BAR;
        PG8_STAGE(PG8_SB(1, 0), cB + kstep, voffB); PG8_STAGE(PG8_SA(1, 0), cA + kstep, voffA); PG8_STAGE(PG8_SB(1, 1), cB + hstep + kstep, voffB);
        PG8_WAIT_V(6); PG8_BAR;
    }
    for (;;) {
        const bool has_next = S.next(ui + 1, nxt);
        const GAS char* nA = has_next ? (const GAS char*)g.A + (size_t)nxt.pm * tstep : cA; const GAS char* nB = has_next ? (const GAS char*)g.Bt + (size_t)nxt.pn * tstep : cB;
        for (int t = 0; t < nt; t += 2) {
            const bool last = (t == nt - 2);
            const GAS char* a1 = cA + (size_t)(t + 1) * kstep;
            const GAS char* a2 = last ? nA : cA + (size_t)(t + 2) * kstep; const GAS char* b2 = last ? nB : cB + (size_t)(t + 2) * kstep;
            const GAS char* a3 = a2 + kstep; const GAS char* b3 = b2 + kstep;
            if constexpr (SP2) {
            PG8_LDB(B0, 0, 0); PG8_LDB(B1, 0, 1); PG8_SCHED; PG8_LDA(At, 0, 0); PG8_STAGE(PG8_SA(1, 1), a1 + hstep, voffA);
            PG8_WAIT_V(8); PG8_WAIT_L(0); PG8_BAR; PG8_MMA(0, 0, At, B0); PG8_MMA(0, 1, At, B1); PG8_BAR; PG8_SCHED;
            PG8_LDA(At, 0, 1); PG8_STAGE(PG8_SB(0, 0), b2, voffB); PG8_STAGE(PG8_SB(0, 1), b2 + hstep, voffB); PG8_STAGE(PG8_SA(0, 0), a2, voffA);
            PG8_WAIT_V(8); PG8_WAIT_L(0); PG8_BAR; PG8_MMA(1, 0, At, B0); PG8_MMA(1, 1, At, B1); PG8_BAR; PG8_SCHED;
            PG8_LDB(B0, 1, 0); PG8_LDB(B1, 1, 1); PG8_SCHED; PG8_LDA(At, 1, 0); PG8_STAGE(PG8_SA(0, 1), a2 + hstep, voffA);
            PG8_WAIT_V(8); PG8_WAIT_L(0); PG8_BAR; PG8_MMA(0, 0, At, B0); PG8_MMA(0, 1, At, B1); PG8_BAR; PG8_SCHED;
            PG8_LDA(At, 1, 1); PG8_STAGE(PG8_SB(1, 0), b3, voffB); PG8_STAGE(PG8_SB(1, 1), b3 + hstep, voffB); PG8_STAGE(PG8_SA(1, 0), a3, voffA);
            PG8_WAIT_V(8); PG8_WAIT_L(0); PG8_BAR; PG8_MMA(1, 0, At, B0); PG8_MMA(1, 1, At, B1); PG8_BAR; PG8_SCHED;
            } else {
            PG8_LDB(B0, 0, 0); PG8_SCHED; PG8_LDA(At, 0, 0); PG8_STAGE(PG8_SA(1, 1), a1 + hstep, voffA);
            PG8_WAIT_L(8); PG8_BAR; PG8_WAIT_L(0); PG8_MMA(0, 0, At, B0); PG8_BAR; PG8_SCHED;
            PG8_LDB(B1, 0, 1); PG8_STAGE(PG8_SB(0, 0), b2, voffB);
            PG8_BAR; PG8_WAIT_L(0); PG8_MMA(0, 1, At, B1); PG8_BAR;
            PG8_LDA(At, 0, 1); PG8_STAGE(PG8_SA(0, 0), a2, voffA);
            PG8_BAR; PG8_WAIT_L(0); PG8_MMA(1, 0, At, B0); PG8_BAR; PG8_SCHED;
            PG8_STAGE(PG8_SB(0, 1), b2 + hstep, voffB);
            PG8_WAIT_V(6); PG8_BAR; PG8_MMA(1, 1, At, B1); PG8_BAR;
            PG8_LDB(B0, 1, 0); PG8_SCHED; PG8_LDA(At, 1, 0); PG8_STAGE(PG8_SA(0, 1), a2 + hstep, voffA);
            PG8_WAIT_L(8); PG8_BAR; PG8_WAIT_L(0); PG8_MMA(0, 0, At, B0); PG8_BAR; PG8_SCHED;
            PG8_LDB(B1, 1, 1); PG8_STAGE(PG8_SB(1, 0), b3, voffB);
            PG8_BAR; PG8_WAIT_L(0); PG8_MMA(0, 1, At, B1); PG8_BAR;
            PG8_LDA(At, 1, 1); PG8_STAGE(PG8_SA(1, 0), a3, voffA);
            PG8_BAR; PG8_WAIT_L(0); PG8_MMA(1, 0, At, B0); PG8_BAR; PG8_SCHED;
            PG8_STAGE(PG8_SB(1, 1), b3 + hstep, voffB);
            PG8_WAIT_V(6); PG8_BAR; PG8_MMA(1, 1, At, B1); PG8_BAR;
            }
        }
        if constexpr (ALIGN_EPI) { if (wr == 0) PG8_BAR; }
        E(acc, cur, wr, wc, fr, fq);
        if (!has_next) break;
        if (nxt.br == 0) {
#pragma unroll
        for (int a = 0; a < 2; ++a)
#pragma unroll
            for (int b = 0; b < 2; ++b)
#pragma unroll
                for (int m = 0; m < 4; ++m)
#pragma unroll
                    for (int n = 0; n < 2; ++n) acc[a][b][m][n] = (f32x4){0.f, 0.f, 0.f, 0.f};
        }
        cur = nxt; cA = nA; cB = nB; ++ui;
        if constexpr (ALIGN_EPI) { if (wr == 1) PG8_BAR; }
    }
    PG8_WAIT_V(0);
    if constexpr (!ALIGN_EPI) { if (wr == 0) PG8_BAR; }
    PG8_BAR;
#undef PG8_SA
#undef PG8_SB
#undef PG8_STAGE
#undef PG8_LDA
#undef PG8_LDB
#undef PG8_MMA
#undef PG8_WAIT_V
#undef PG8_WAIT_L
#undef PG8_BAR
#undef PG8_SCHED
}

struct EpiInProj {
    static constexpr bool PERM = true;
    GAS bf16_t* Z; const GAS float* bias; const GAS float* rope; GAS bf16_t* KC; GAS bf16_t* VC;
    __device__ __forceinline__ void operator()(f32x4 (&acc)[2][2][4][2], const Unit& u, int wr, int wc, int fr, int fq) const {
        const int colt = u.rn * BM, cb = colt >> 10, tt = u.rm % TILES_B;
        const int col0 = colt + wc * 32 + 8 * fq;
        const bool do_rope = (tt != 0) && (cb == 2 || cb == 3);
        const float sc = (cb == 2) ? C2 : 1.f;
        f32x4 bv[2][2];
#pragma unroll
        for (int bj = 0; bj < 2; ++bj)
#pragma unroll
            for (int n = 0; n < 2; ++n) bv[bj][n] = *(const GAS f32x4*)(bias + col0 + bj * HALF + 4 * n);
#pragma unroll
        for (int ai = 0; ai < 2; ++ai)
#pragma unroll
            for (int m = 0; m < 4; ++m) {
                const int rit = ai * HALF + wr * 64 + m * 16 + fr;
                GAS bf16_t* rowp = Z + (size_t)(u.rm * BM + rit) * DIN + col0; size_t bjstep = HALF;
                if (cb == 3 || cb == 4) {
                    const int bl_ = u.rm / TILES_B, rib = (u.rm % TILES_B) * BM + rit, cc = col0 & 1023, hh = cc >> 7;
                    if (cb == 3) { rowp = KC + ((size_t)((bl_ * 8 + hh) * 2 + ((cc >> 6) & 1)) * RB + rib) * 64 + (cc & 63); bjstep = (size_t)2 * RB * 64; }
                    else { rowp = VC + ((size_t)(bl_ * 8 + hh) * RB + rib) * 128 + (cc & 127); bjstep = (size_t)RB * 128; } }
                f32x4 cs[4];
                if (do_rope) { const int t = (tt - 1) * 256 + rit; const int pos = (wc & 1) ? (t & 63) : (t >> 6);
                    const GAS f32x4* tp = (const GAS f32x4*)(rope + (pos * 16 + 8 * (fq & 1)) * 2);
                    cs[0] = tp[0]; cs[1] = tp[1]; cs[2] = tp[2]; cs[3] = tp[3]; }
#pragma unroll
                for (int bj = 0; bj < 2; ++bj) {
                    f32x4 v0 = acc[ai][bj][m][0] + bv[bj][0], v1 = acc[ai][bj][m][1] + bv[bj][1];
                    if (do_rope) {
                        float x[8] = {v0[0], v0[1], v0[2], v0[3], v1[0], v1[1], v1[2], v1[3]};
#pragma unroll
                        for (int i = 0; i < 8; ++i) { const float p = __shfl_xor(x[i], 32); const float c = cs[i >> 1][(i & 1) * 2], s = cs[i >> 1][(i & 1) * 2 + 1];
                            x[i] = x[i] * c + ((fq < 2) ? -p * s : p * s); }
                        v0 = (f32x4){x[0], x[1], x[2], x[3]}; v1 = (f32x4){x[4], x[5], x[6], x[7]};
                    }
                    v0 = v0 * sc; v1 = v1 * sc;
                    u32x4 w; w.x = pk_bf16(v0[0], v0[1]); w.y = pk_bf16(v0[2], v0[3]); w.z = pk_bf16(v1[0], v1[1]); w.w = pk_bf16(v1[2], v1[3]);
                    *(GAS u32x4*)(rowp + bj * bjstep) = w;
                }
            }
    }
};
struct EpiMerge {
    static constexpr bool PERM = true;
    const GAS bf16_t* Z; GAS bf16_t* O; GAS float* PART;
    __device__ __forceinline__ void operator()(f32x4 (&acc)[2][2][4][2], const Unit& u, int wr, int wc, int fr, int fq) const {
        const bool part = u.xb >= 0; const int br = part ? u.xb : u.br; const bool fin = part || br == 2;
        const int col0 = u.rn * BM + wc * 32 + 8 * fq;
        const int prow0 = part ? (u.xb * (GB * CL) + (u.rm / TILES_B) * CL) : 0;
#pragma unroll
        for (int ai = 0; ai < 2; ++ai)
#pragma unroll
            for (int m = 0; m < 4; ++m) {
                const int rit = ai * HALF + wr * 64 + m * 16 + fr; const int row = u.rm * BM + rit;
                const GAS bf16_t* zr = Z + (size_t)row * DIN + ZC_MG + col0;
#pragma unroll
                for (int bj = 0; bj < 2; ++bj) {
                    const u32x4 gc = *(const GAS u32x4*)(zr + br * 1024 + bj * HALF);
                    u32x4 gn = (u32x4){0u, 0u, 0u, 0u};
                    if (!fin) gn = *(const GAS u32x4*)(zr + (br + 1) * 1024 + bj * HALF);
                    float c[8], nx[8], r[8]; unpack8(gc, c); unpack8(gn, nx);
#pragma unroll
                    for (int i = 0; i < 8; ++i) { const float den = 1.f + __expf(-c[i]); const float num = fin ? 1.f : 1.f + __expf(-nx[i]); r[i] = num * __builtin_amdgcn_rcpf(den); }
                    f32x4 v0 = acc[ai][bj][m][0] * (f32x4){r[0], r[1], r[2], r[3]}, v1 = acc[ai][bj][m][1] * (f32x4){r[4], r[5], r[6], r[7]};
                    acc[ai][bj][m][0] = v0; acc[ai][bj][m][1] = v1;
                    if (part) { GAS float* pp = PART + (size_t)(prow0 + rit) * D + col0 + bj * HALF; *(GAS f32x4*)pp = v0; *(GAS f32x4*)(pp + 4) = v1; }
                    else if (fin) { u32x4 w; w.x = pk_bf16(v0[0], v0[1]); w.y = pk_bf16(v0[2], v0[3]); w.z = pk_bf16(v1[0], v1[1]); w.w = pk_bf16(v1[2], v1[3]);
                        *(GAS u32x4*)(O + (size_t)row * D + col0 + bj * HALF) = w; }
                }
            }
    }
};
struct EpiOut {
    static constexpr bool PERM = true;
    const GAS float* srcX; const GAS float* srcC; GAS float* dstX; GAS float* dstC; const GAS float* mod; int grp;
    __device__ __forceinline__ void operator()(f32x4 (&acc)[2][2][4][2], const Unit& u, int wr, int wc, int fr, int fq) const {
        const int bl = u.rm / TILES_B, tt = u.rm % TILES_B, b = grp * GB + bl;
        const int col0 = u.rn * BM + wc * 32 + 8 * fq;
        const GAS float* gt = mod + (size_t)(tt == 0 ? 16 : b) * 3072 + 2048 + col0;
        f32x4 gv[2][2];
#pragma unroll
        for (int bj = 0; bj < 2; ++bj)
#pragma unroll
            for (int n = 0; n < 2; ++n) gv[bj][n] = *(const GAS f32x4*)(gt + bj * HALF + 4 * n);
#pragma unroll
        for (int ai = 0; ai < 2; ++ai)
#pragma unroll
            for (int m = 0; m < 4; ++m) {
                const int rit = ai * HALF + wr * 64 + m * 16 + fr;
                const size_t off = (tt == 0) ? ((size_t)(b * CL + rit) * D + col0) : (((size_t)b * T + (tt - 1) * 256 + rit) * D + col0);
                const GAS float* sp = (tt == 0 ? srcC : srcX) + off; GAS float* dp = (tt == 0 ? dstC : dstX) + off;
#pragma unroll
                for (int bj = 0; bj < 2; ++bj)
#pragma unroll
                    for (int n = 0; n < 2; ++n) { const f32x4 xr = *(const GAS f32x4*)(sp + bj * HALF + 4 * n);
                        *(GAS f32x4*)(dp + bj * HALF + 4 * n) = xr * ALPHA + gv[bj][n] * acc[ai][bj][m][n]; }
            }
    }
};
}

struct Params {
    const float* in[25];
    float* out; unsigned char* ws;
};
struct DP { const GAS float* in[25]; GAS float* out; GAS unsigned char* ws; };
enum { I_X = 0, I_C, I_CTX, I_CCTX, I_WADA, I_BADA, I_WIN, I_BIN, I_CONVW, I_CONVB, I_LWA, I_LBA, I_LWX, I_LBX, I_LLAM, I_DLAM, I_DNG, I_SLG, I_SLB, I_SW, I_SB, I_WBR, I_WOUT, I_LNG, I_LNB };

__device__ __forceinline__ void transpose_item(const GAS float* W, int K, int N, GAS bf16_t* WT, float* scr, int item, int lane) {
    const int nblk = N / 32, kb = item / nblk, nb = item % nblk, k0 = 64 * kb, n0 = 32 * nb;
#pragma unroll 8
    for (int i = 0; i < 32; ++i) { const int kk = 2 * i + (lane >> 5); scr[kk * 33 + (lane & 31)] = W[(size_t)(k0 + kk) * N + n0 + (lane & 31)]; }
    LDS_WAIT(); __builtin_amdgcn_wave_barrier();
    const int c = lane & 7;
#pragma unroll
    for (int j = 0; j < 4; ++j) { const int n = (lane >> 3) + 8 * j; const float* s = scr + (8 * c) * 33 + n;
        u32x4 o; o.x = pk_bf16(s[0 * 33], s[1 * 33]); o.y = pk_bf16(s[2 * 33], s[3 * 33]); o.z = pk_bf16(s[4 * 33], s[5 * 33]); o.w = pk_bf16(s[6 * 33], s[7 * 33]);
        *(GAS u32x4*)(WT + (size_t)(n0 + n) * K + k0 + 8 * c) = o; }
    LDS_WAIT(); __builtin_amdgcn_wave_barrier();
}

__device__ __forceinline__ void phase_prologue(const DP& p, unsigned char* smem) {
    const int tid = opq_v(threadIdx.x), lane = tid & 63, wid = tid >> 6;
    GAS unsigned char* ws = p.ws;
    if (blockIdx.x < 48) {
        float* sl = (float*)(smem + 70 * 1024);
        float* part = (float*)smem;
        for (int i = tid; i < 17 * 1024; i += NTHR) { const int bb = i >> 10, k = i & 1023; const float v = (bb < 16) ? p.in[I_C][bb * 1024 + k] : p.in[I_CCTX][k]; sl[i] = siluf_(v); }
        __syncthreads();
        const int l = blockIdx.x / 24, cix = tid & 127, n = (blockIdx.x % 24) * 128 + cix, kq = tid >> 7;
        float acc[17];
#pragma unroll
        for (int bb = 0; bb < 17; ++bb) acc[bb] = 0.f;
        const GAS float* w = p.in[I_WADA] + ((size_t)l * 1024 + kq * 256) * 3072 + n;
        const float* slq = sl + kq * 256;
        for (int k0 = 0; k0 < 256; k0 += 16) {
            float wv[16];
#pragma unroll
            for (int i = 0; i < 16; ++i) wv[i] = w[(size_t)(k0 + i) * 3072];
#pragma unroll
            for (int i = 0; i < 16; ++i)
#pragma unroll
                for (int bb = 0; bb < 17; ++bb) acc[bb] += slq[bb * 1024 + k0 + i] * wv[i];
        }
#pragma unroll
        for (int bb = 0; bb < 17; ++bb) part[(kq * 17 + bb) * 128 + cix] = acc[bb];
        __syncthreads();
        if (kq == 0) {
            const float bias = p.in[I_BADA][l * 3072 + n];
            GAS float* mod = (GAS float*)(ws + WS_MOD);
#pragma unroll
            for (int bb = 0; bb < 17; ++bb) mod[(size_t)(l * 17 + bb) * 3072 + n] = ((part[bb * 128 + cix] + part[(17 + bb) * 128 + cix]) + (part[(34 + bb) * 128 + cix] + part[(51 + bb) * 128 + cix])) + bias;
        }
        __syncthreads();
    }
    if (blockIdx.x == 48) {
        GAS float* rope = (GAS float*)(ws + WS_ROPE);
        for (int i = tid; i < 64 * 16; i += NTHR) { const int pos = i >> 4, f = i & 15; const float fr = powf(10000.f, -(float)f / 16.f); const float ang = (float)pos * fr;
            float s, c; sincosf(ang, &s, &c); rope[i * 2] = c; rope[i * 2 + 1] = s; }
    }
    if (blockIdx.x == 49 && tid < NL) {
        const GAS float* dl = p.in[I_DLAM] + tid * 256; float s1 = 0.f, s2 = 0.f;
        for (int i = 0; i < 64; ++i) { s1 += dl[i] * dl[64 + i]; s2 += dl[128 + i] * dl[192 + i]; }
        const float lam_init = 0.8f - 0.6f * expf(-0.3f * (float)tid);
        ((GAS float*)(ws + WS_SCAL))[tid] = expf(s1) - expf(s2) + lam_init;
    }
    float* scr = (float*)(smem + wid * 8704);
    const int gw = ((int)blockIdx.x - 48) * NWAVES + wid, NGW = ((int)gridDim.x - 48) * NWAVES;
    constexpr int I_IN = 16 * 384, I_SQ = 16 * 32, I_LR = 8;
    constexpr int N_IN = NL * I_IN, N_BR = NL * 3 * I_SQ, N_OUT = NL * I_SQ, N_LR = 64 * I_LR;
    for (int it = (gw >= 0 ? gw : 0x40000000); it < N_IN + N_BR + N_OUT + N_LR; it += NGW) {
        int r = it;
        if (r < N_IN) { const int l = r / I_IN; transpose_item(p.in[I_WIN] + (size_t)l * D * DIN, D, DIN, (GAS bf16_t*)(ws + WS_WIN) + (size_t)l * DIN * D, scr, r % I_IN, lane); continue; } r -= N_IN;
        if (r < N_BR) { const int mi = r / I_SQ; transpose_item(p.in[I_WBR] + (size_t)mi * D * D, D, D, (GAS bf16_t*)(ws + WS_WBR) + (size_t)mi * D * D, scr, r % I_SQ, lane); continue; } r -= N_BR;
        if (r < N_OUT) { const int l = r / I_SQ; transpose_item(p.in[I_WOUT] + (size_t)l * D * D, D, D, (GAS bf16_t*)(ws + WS_WOUT) + (size_t)l * D * D, scr, r % I_SQ, lane); continue; } r -= N_OUT;
        { const int mi = r / I_LR; const int g = mi & 7, gate = (mi >> 3) & 1, ld = mi >> 4;
          const GAS float* src = (gate == 0 ? p.in[I_LWA] : p.in[I_LWX]) + (size_t)(ld * 8 + g) * 16384;
          transpose_item(src, 128, 128, (GAS bf16_t*)(ws + WS_LRUW) + (size_t)mi * 16384, scr, r % I_LR, lane); }
    }
    { GAS bf16_t* sw = (GAS bf16_t*)(ws + WS_SGUW); const GAS float* s = p.in[I_SW];
      for (int i = blockIdx.x * NTHR + tid; i < NL * 8 * 16384 / 2; i += gridDim.x * NTHR) ((GAS unsigned*)sw)[i] = pk_bf16(s[2 * i], s[2 * i + 1]); }
}

__device__ __forceinline__ void phase_xm0(const DP& p, int grp) {
    const int tid = opq_v(threadIdx.x), lane = tid & 63, wid = tid >> 6;
    const int gw = blockIdx.x * NWAVES + wid, NGW = gridDim.x * NWAVES;
    const GAS float* mod = (const GAS float*)(p.ws + WS_MOD);
    GAS bf16_t* xm = (GAS bf16_t*)(p.ws + WS_XM);
    for (int rg = gw; rg < RG; rg += NGW) {
        const int bl = rg / RB, rr = rg % RB, b = grp * GB + bl;
        const GAS float* src = (rr < CL) ? p.in[I_CTX] + (size_t)(b * CL + rr) * D : p.in[I_X] + ((size_t)b * T + rr - CL) * D;
        const GAS float* md = mod + (size_t)(rr < CL ? 16 : b) * 3072;
        GAS u32x2* o = (GAS u32x2*)(xm + (size_t)rg * D) + lane;
#pragma unroll
        for (int j = 0; j < 4; ++j) { const f32x4 v = ((const GAS f32x4*)src)[lane + 64 * j]; const f32x4 sh = ((const GAS f32x4*)md)[lane + 64 * j], sc = ((const GAS f32x4*)(md + 1024))[lane + 64 * j];
            const f32x4 r = v * (sc + 1.f) + sh; u32x2 w; w.x = pk_bf16(r[0], r[1]); w.y = pk_bf16(r[2], r[3]); o[64 * j] = w; }
    }
}
__device__ __forceinline__ void phase_ln(const DP& p, int grp, int l, bool ctx_only = false) {
    const int tid = opq_v(threadIdx.x), lane = tid & 63, wid = tid >> 6;
    const int gw = blockIdx.x * NWAVES + wid, NGW = gridDim.x * NWAVES;
    const GAS float* mod1 = (const GAS float*)(p.ws + WS_MOD) + (size_t)17 * 3072;
    GAS bf16_t* xm = (GAS bf16_t*)(p.ws + WS_XM);
    const GAS float* lg = p.in[I_LNG] + l * D; const GAS float* lb = p.in[I_LNB] + l * D;
    f32x4 g4[4], b4[4];
#pragma unroll
    for (int j = 0; j < 4; ++j) { g4[j] = ((const GAS f32x4*)lg)[lane + 64 * j]; b4[j] = ((const GAS f32x4*)lb)[lane + 64 * j]; }
    const int n_rows = ctx_only ? GB * CL : ((l == 0) ? RG : GB * T);
#define LN_ROW(i, rgv, bufv, bbv) do { int rg_, rr_; if (ctx_only) { rr_ = (i) % CL; rg_ = ((i) / CL) * RB + rr_; } else if (l == 0) { rg_ = (i); rr_ = rg_ % RB; } else { rr_ = CL + ((i) % T); rg_ = ((i) / T) * RB + rr_; } const int b_ = grp * GB + rg_ / RB; \
        rgv = rg_; bbv = (rr_ < CL) ? 16 : b_; bufv = (rr_ < CL) ? (GAS float*)(p.ws + WS_CTX1) + (size_t)(b_ * CL + rr_) * D : p.out + ((size_t)b_ * T + rr_ - CL) * D; } while (0)
    f32x4 nv[4]; int nrg = 0, nbb = 0; GAS float* nbuf = nullptr;
    if (gw < n_rows) { LN_ROW(gw, nrg, nbuf, nbb);
#pragma unroll
        for (int j = 0; j < 4; ++j) nv[j] = ((const GAS f32x4*)nbuf)[lane + 64 * j]; }
    for (int i = gw; i < n_rows; i += NGW) {
        const int rg = nrg, bb = nbb; GAS float* buf = nbuf;
        f32x4 v[4]; float s = 0.f;
#pragma unroll
        for (int j = 0; j < 4; ++j) { v[j] = nv[j]; s += (v[j][0] + v[j][1]) + (v[j][2] + v[j][3]); }
        if (i + NGW < n_rows) { LN_ROW(i + NGW, nrg, nbuf, nbb);
#pragma unroll
            for (int j = 0; j < 4; ++j) nv[j] = ((const GAS f32x4*)nbuf)[lane + 64 * j]; }
        const float mean = wave_sum(s) * (1.f / D); float s2 = 0.f;
#pragma unroll
        for (int j = 0; j < 4; ++j) { v[j] = v[j] - mean; s2 += (v[j][0] * v[j][0] + v[j][1] * v[j][1]) + (v[j][2] * v[j][2] + v[j][3] * v[j][3]); }
        const float rstd = 1.f / sqrtf(wave_sum(s2) * (1.f / D) + 1e-5f);
#pragma unroll
        for (int j = 0; j < 4; ++j) { v[j] = v[j] * rstd * g4[j] + b4[j]; ((GAS f32x4*)buf)[lane + 64 * j] = v[j]; }
        if (l == 0) {
            const GAS float* md = mod1 + (size_t)bb * 3072;
            GAS u32x2* o = (GAS u32x2*)(xm + (size_t)rg * D) + lane;
#pragma unroll
            for (int j = 0; j < 4; ++j) { const f32x4 sh = ((const GAS f32x4*)md)[lane + 64 * j], sc = ((const GAS f32x4*)(md + 1024))[lane + 64 * j];
                const f32x4 r = v[j] * (sc + 1.f) + sh; u32x2 w; w.x = pk_bf16(r[0], r[1]); w.y = pk_bf16(r[2], r[3]); o[64 * j] = w; }
        }
    }
#undef LN_ROW
}

__device__ __forceinline__ int crow(int r, int hi) { return (r & 3) + 8 * (r >> 2) + 4 * hi; }
typedef short v4i16_t __attribute__((ext_vector_type(4)));
__device__ __forceinline__ s16x4 vtr(LAS const unsigned char* p) { return __builtin_bit_cast(s16x4, __builtin_amdgcn_ds_read_tr16_b64_v4i16((LAS v4i16_t*)p)); }
__device__ __forceinline__ void glds16(const GAS void* gsrc, unsigned lds_dst) { unsigned keep;
    asm volatile("s_mov_b32 %0, m0\n\ts_mov_b32 m0, %2\n\ts_nop 0\n\tglobal_load_lds_dwordx4 %1, off\n\ts_mov_b32 m0, %0" : "=&s"(keep) : "v"(gsrc), "s"(lds_dst) : "memory"); }
__device__ __forceinline__ void glds16s(unsigned long long sbase, unsigned voff, unsigned lds_dst) { unsigned keep;
    asm volatile("s_mov_b32 %0, m0\n\ts_mov_b32 m0, %3\n\ts_nop 0\n\tglobal_load_lds_dwordx4 %1, %2\n\ts_mov_b32 m0, %0" : "=&s"(keep) : "v"(voff), "s"(sbase), "s"(lds_dst) : "memory"); }
__device__ __forceinline__ unsigned long long uni64(unsigned long long v) { return ((unsigned long long)(unsigned)__builtin_amdgcn_readfirstlane((int)(v >> 32)) << 32) | (unsigned)__builtin_amdgcn_readfirstlane((int)(unsigned)v); }
#define WAIT_BAR(N) asm volatile("s_waitcnt vmcnt(" #N ") lgkmcnt(0)\n\ts_barrier" ::: "memory")
#define MX3(a, b, c) __builtin_fmaxf(__builtin_fmaxf((a), (b)), (c))
#define SBAR() __builtin_amdgcn_sched_barrier(0)

constexpr int AT_K = 0, AT_V = 40960, AT_SCR = 122880;
__device__ __forceinline__ void attn_unit(const DP& p, unsigned char* smem, int l, int bl, int h, int qb) {
    const int tid = opq_v(threadIdx.x), lane = tid & 63, r32 = lane & 31, hi = lane >> 5; const int wid = __builtin_amdgcn_readfirstlane(tid >> 6);
    LAS unsigned char* lds3 = (LAS unsigned char*)smem;
    const GAS bf16_t* z = (const GAS bf16_t*)(p.ws + WS_Z);
    GAS bf16_t* bin = (GAS bf16_t*)(p.ws + WS_AIN) + (size_t)RG * D;
    const int rowb = bl * RB, qrow0 = rowb + qb * 256 + wid * 32;
    const int NT = (qb == 0) ? 4 : 68;
    const float lam = ((const GAS float*)(p.ws + WS_SCAL))[l];
    const float lam_init = 0.8f - 0.6f * expf(-0.3f * (float)l);
    float* scr = (float*)(smem + AT_SCR) + wid * 64;
    unsigned ofp[4][8];
    const int vcol = ZC_V + h * 128;
    const unsigned long long vbase = uni64((unsigned long long)(size_t)(p.ws + WS_VC) + ((size_t)(bl * 8 + h) * RB) * 256);
    const unsigned voffV = (unsigned)(((16 * (wid & 3) + (lane >> 2)) * 128 + (wid >> 2) * 32 + (lane & 3) * 8) * 2);
    const unsigned voffK = (unsigned)((lane * 64 + wid * 8) * 2);
    LAS const unsigned char* vp0 = lds3 + AT_V + ((lane >> 4) & 1) * 32 + (lane & 3) * 8 + (4 * hi + ((lane & 15) >> 2)) * 64;
    const unsigned lds0 = (unsigned)(size_t)lds3;
    const unsigned kdst = (unsigned)__builtin_amdgcn_readfirstlane(lds0 + AT_K + wid * 1024);
    const unsigned vdst = (unsigned)__builtin_amdgcn_readfirstlane(lds0 + AT_V + wid * 1024);
    f32x16 o[4];
    for (int mp = 0; mp < 2; ++mp) {
        bf16x8 qr[4];
        { const GAS bf16_t* qp = z + (size_t)(qrow0 + r32) * DIN + ZC_Q + h * 128 + mp * 64 + hi * 8;
#pragma unroll
          for (int d0 = 0; d0 < 4; ++d0) qr[d0] = *(const GAS bf16x8*)(qp + d0 * 16); }
        asm volatile("" :: "v"(qr[0]), "v"(qr[1]), "v"(qr[2]), "v"(qr[3]));
        const unsigned long long kbase = uni64((unsigned long long)(size_t)(p.ws + WS_KC) + ((size_t)((bl * 8 + h) * 2 + mp) * RB) * 128);
#pragma unroll
        for (int e = 0; e < 4; ++e) o[e] = f32x16{};
        float mrun = 0.f, lsum = 0.f; f32x16 negm = f32x16{};
#pragma unroll
        for (int u = 0; u < 4; ++u) { glds16s(kbase + (unsigned long long)u * 8192, voffK, kdst + u * 8192); glds16s(vbase + (unsigned long long)u * 16384, voffV, vdst + u * 16384); glds16s(vbase + (unsigned long long)u * 16384, voffV + 128, vdst + u * 16384 + 8192); }
        WAIT_BAR(9);
        int cur = 0;
        for (int t = 0; t < NT; ++t) {
            if (t + 4 < NT) { const unsigned long long kb4 = kbase + (unsigned long long)(t + 4) * 8192, vb4 = vbase + (unsigned long long)(t + 4) * 16384; const int nb = (cur >= 1) ? cur - 1 : 4;
                glds16s(kb4, voffK, kdst + nb * 8192); glds16s(vb4, voffV, vdst + nb * 16384); glds16s(vb4, voffV + 128, vdst + nb * 16384 + 8192); }
            LAS const unsigned char* kb = lds3 + AT_K + cur * 8192 + hi * 1024 + r32 * 16;
            LAS const unsigned char* vp = vp0 + cur * 16384;
            bf16x8 kf[8];
#pragma unroll
            for (int d0 = 0; d0 < 4; ++d0) { kf[2 * d0] = *(const LAS bf16x8*)(kb + d0 * 2048); kf[2 * d0 + 1] = *(const LAS bf16x8*)(kb + d0 * 2048 + 512); }
            s16x4 va[8], vb[8];
            SBAR();
            f32x16 p0, p1;
            p0 = __builtin_amdgcn_mfma_f32_32x32x16_bf16(kf[0], qr[0], negm, 0, 0, 0); p1 = __builtin_amdgcn_mfma_f32_32x32x16_bf16(kf[1], qr[0], negm, 0, 0, 0);
#pragma unroll
            for (int d0 = 1; d0 < 4; ++d0) { p0 = __builtin_amdgcn_mfma_f32_32x32x16_bf16(kf[2 * d0], qr[d0], p0, 0, 0, 0); p1 = __builtin_amdgcn_mfma_f32_32x32x16_bf16(kf[2 * d0 + 1], qr[d0], p1, 0, 0, 0); }
            float mx;
            { float a = MX3(p0[0], p0[1], p1[0]), b = MX3(p0[2], p0[3], p1[1]); a = MX3(a, p1[2], p1[3]);
#pragma unroll
              for (int r = 4; r < 16; r += 4) { a = MX3(a, p0[r], p0[r + 1]); b = MX3(b, p0[r + 2], p0[r + 3]); a = MX3(a, p1[r], p1[r + 1]); b = MX3(b, p1[r + 2], p1[r + 3]); }
              mx = fmaxf(a, b); mx = fmaxf(mx, __shfl_xor(mx, 32)); }
            if (t == 0 || __any(mx > 8.f)) {
                const float dl = (t == 0) ? mx : fmaxf(mx, 0.f); const float f = (t == 0) ? 1.f : __builtin_amdgcn_exp2f(-dl); mrun += dl; lsum *= f;
#pragma unroll
                for (int r = 0; r < 16; ++r) { p0[r] -= dl; p1[r] -= dl; negm[r] = -mrun; }
                if (hi == 0) scr[r32] = f;
                LDS_WAIT(); __builtin_amdgcn_wave_barrier();
#pragma unroll
                for (int r = 0; r < 16; ++r) { const float fr_ = scr[crow(r, hi)];
#pragma unroll
                    for (int e = 0; e < 4; ++e) o[e][r] *= fr_; }
                LDS_WAIT(); __builtin_amdgcn_wave_barrier();
            }
            f32x2 sacc2 = {0.f, 0.f}; u32x4 pw[4];
#define EXPPAIR(P, base, c, j) do { const float x0_ = __builtin_amdgcn_exp2f(P[(base) + 2 * (j)]), x1_ = __builtin_amdgcn_exp2f(P[(base) + 2 * (j) + 1]); sacc2 += (f32x2){x0_, x1_}; pw[c][j] = pk_bf16(x0_, x1_); } while (0)
#define VLOADK(F, ks) do { _Pragma("unroll") for (int e = 0; e < 4; ++e) { F[2 * e] = vtr(vp + e * 4096 + (ks) * 1024); F[2 * e + 1] = vtr(vp + e * 4096 + (ks) * 1024 + 512); } } while (0)
#define FR(F, e) ((bf16x8){F[2 * (e)][0], F[2 * (e)][1], F[2 * (e)][2], F[2 * (e)][3], F[2 * (e) + 1][0], F[2 * (e) + 1][1], F[2 * (e) + 1][2], F[2 * (e) + 1][3]})
#define PVK(F, c, e) o[e] = __builtin_amdgcn_mfma_f32_32x32x16_bf16(__builtin_bit_cast(bf16x8, pw[c]), FR(F, e), o[e], 0, 0, 0)
            VLOADK(va, 0);
            EXPPAIR(p0, 0, 0, 0); EXPPAIR(p0, 0, 0, 1); EXPPAIR(p0, 0, 0, 2); EXPPAIR(p0, 0, 0, 3);
            SBAR();
            VLOADK(vb, 1);
            PVK(va, 0, 0); EXPPAIR(p0, 8, 1, 0); SBAR(); PVK(va, 0, 1); EXPPAIR(p0, 8, 1, 1); SBAR(); PVK(va, 0, 2); EXPPAIR(p0, 8, 1, 2); SBAR(); PVK(va, 0, 3); EXPPAIR(p0, 8, 1, 3); SBAR();
            VLOADK(va, 2);
            PVK(vb, 1, 0); EXPPAIR(p1, 0, 2, 0); SBAR(); PVK(vb, 1, 1); EXPPAIR(p1, 0, 2, 1); SBAR(); PVK(vb, 1, 2); EXPPAIR(p1, 0, 2, 2); SBAR(); PVK(vb, 1, 3); EXPPAIR(p1, 0, 2, 3); SBAR();
            VLOADK(vb, 3);
            PVK(va, 2, 0); EXPPAIR(p1, 8, 3, 0); SBAR(); PVK(va, 2, 1); EXPPAIR(p1, 8, 3, 1); SBAR(); PVK(va, 2, 2); EXPPAIR(p1, 8, 3, 2); SBAR(); PVK(va, 2, 3); EXPPAIR(p1, 8, 3, 3); SBAR();
            PVK(vb, 3, 0); PVK(vb, 3, 1); PVK(vb, 3, 2); PVK(vb, 3, 3); SBAR();
            lsum += sacc2[0] + sacc2[1];
#undef EXPPAIR
#undef VLOADK
#undef FR
#undef PVK
            if (t + 4 < NT) WAIT_BAR(9); else if (t + 3 < NT) WAIT_BAR(6); else if (t + 2 < NT) WAIT_BAR(3); else WAIT_BAR(0);
            cur = (cur == 4) ? 0 : cur + 1;
        }
        const float ltot = lsum + __shfl_xor(lsum, 32);
        if (hi == 0) scr[r32] = 1.f / ltot;
        LDS_WAIT(); __builtin_amdgcn_wave_barrier();
        if (mp == 0) {
#pragma unroll
            for (int r = 0; r < 16; r += 2) { const float rl0 = scr[crow(r, hi)], rl1 = scr[crow(r + 1, hi)];
#pragma unroll
                for (int e = 0; e < 4; ++e) ofp[e][r >> 1] = pk_bf16(o[e][r] * rl0, o[e][r + 1] * rl1); }
        } else {
#pragma unroll
            for (int r = 0; r < 16; ++r) { const float rl = scr[crow(r, hi)];
#pragma unroll
                for (int e = 0; e < 4; ++e) { const float o0 = (r & 1) ? bfhi(ofp[e][r >> 1]) : bflo(ofp[e][r >> 1]); o[e][r] = o0 - lam * (o[e][r] * rl); } }
        }
        LDS_WAIT(); __builtin_amdgcn_wave_barrier();
    }
    float ss[16];
#pragma unroll
    for (int r = 0; r < 16; ++r) { float s = 0.f;
#pragma unroll
        for (int e = 0; e < 4; ++e) s += o[e][r] * o[e][r];
        ss[r] = s; }
#pragma unroll
    for (int off = 1; off < 32; off <<= 1)
#pragma unroll
        for (int r = 0; r < 16; ++r) ss[r] += __shfl_xor(ss[r], off);
    const GAS float* ng = p.in[I_DNG] + l * 128;
    float gn[4];
#pragma unroll
    for (int e = 0; e < 4; ++e) gn[e] = ng[32 * e + r32] * (1.f - lam_init);
#pragma unroll
    for (int r = 0; r < 16; ++r) {
        const float sc = 1.f / sqrtf(ss[r] * (1.f / 128.f) + 1e-5f);
        const int row = qrow0 + crow(r, hi);
#pragma unroll
        for (int e = 0; e < 4; ++e) { const int col = h * 128 + 32 * e + r32; const float gate = bf1(z[(size_t)row * DIN + ZC_BG + col]);
            bin[(size_t)row * D + col] = f2bf(o[e][r] * sc * gn[e] * siluf_(gate)); }
    }
}
#undef MX3
#undef SBAR

constexpr int LR_RAW = 0;
constexpr int LR_XC = 34816;
constexpr int LR_O1 = 69632;
constexpr int LR_O2 = 104448;
template <int DIR> __device__ __forceinline__ void lru_scan_chunk(const float (&av)[8][4], const float (&bv)[8][4], float (&hv)[8][4], float (&pv)[8][4], float& ptot, float& hend, int lane) {
    const int q = lane >> 4;
    float A1[8][4], B1[8][4], EA[8], EB[8], TA[8], TB[8];
#pragma unroll
    for (int m = 0; m < 8; ++m) {
        if (DIR == 0) { A1[m][0] = av[m][0]; B1[m][0] = bv[m][0];
#pragma unroll
            for (int j = 1; j < 4; ++j) { A1[m][j] = av[m][j] * A1[m][j - 1]; B1[m][j] = av[m][j] * B1[m][j - 1] + bv[m][j]; } }
        else { A1[m][3] = av[m][3]; B1[m][3] = bv[m][3];
#pragma unroll
            for (int j = 2; j >= 0; --j) { A1[m][j] = av[m][j] * A1[m][j + 1]; B1[m][j] = av[m][j] * B1[m][j + 1] + bv[m][j]; } }
        float IA = (DIR == 0) ? A1[m][3] : A1[m][0], IB = (DIR == 0) ? B1[m][3] : B1[m][0];
#pragma unroll
        for (int s = 1; s <= 2; s <<= 1) {
            const int src = (DIR == 0) ? lane - 16 * s : lane + 16 * s;
            const float pa = __shfl(IA, src & 63), pb = __shfl(IB, src & 63);
            const bool ok = (DIR == 0) ? (q >= s) : (q + s <= 3);
            if (ok) { IB = IA * pb + IB; IA = IA * pa; }
        }
        { const int src = (DIR == 0) ? lane - 16 : lane + 16; const float ea = __shfl(IA, src & 63), eb = __shfl(IB, src & 63);
          const bool first = (DIR == 0) ? (q == 0) : (q == 3); EA[m] = first ? 1.f : ea; EB[m] = first ? 0.f : eb; }
        { const int src = (DIR == 0) ? 48 + (lane & 15) : (lane & 15); TA[m] = __shfl(IA, src); TB[m] = __shfl(IB, src); }
    }
    float hin = 0.f, pin = 1.f;
#pragma unroll
    for (int mm = 0; mm < 8; ++mm) { const int m = (DIR == 0) ? mm : 7 - mm;
        const float hq = EA[m] * hin + EB[m], aq = EA[m] * pin;
#pragma unroll
        for (int j = 0; j < 4; ++j) { hv[m][j] = A1[m][j] * hq + B1[m][j]; pv[m][j] = A1[m][j] * aq; }
        hin = TA[m] * hin + TB[m]; pin = TA[m] * pin; }
    ptot = pin; hend = hin;
}

struct LruW { bf16x8 fa[4], fx[4]; float ba, bx, lm; };
__device__ __forceinline__ void lru_load_w(const DP& p, int l, int dir, int g, int lane, int wid, LruW& w) {
    const int ld = l * 2 + dir;
    const GAS bf16_t* wa = (const GAS bf16_t*)(p.ws + WS_LRUW) + (size_t)((ld * 2 + 0) * 8 + g) * 16384 + (size_t)(16 * wid + (lane & 15)) * 128 + (lane >> 4) * 8;
    const GAS bf16_t* wx = wa + (size_t)8 * 16384;
#pragma unroll
    for (int ks = 0; ks < 4; ++ks) { w.fa[ks] = *(const GAS bf16x8*)(wa + ks * 32); w.fx[ks] = *(const GAS bf16x8*)(wx + ks * 32); }
    const int ch = g * 128 + 16 * wid + (lane & 15);
    w.ba = p.in[I_LBA][ld * D + ch]; w.bx = p.in[I_LBX][ld * D + ch]; w.lm = p.in[I_LLAM][ld * D + ch];
}
template <int DIR> __device__ __forceinline__ void lru_dir(const DP& p, unsigned char* smem, int l, int bl, int g, int cidx, float (&hsum)[8][4], int lane, int wid, const LruW& w) {
    const bf16_t* xcs = (const bf16_t*)(smem + LR_XC);
    bf16_t* po = (bf16_t*)(smem + (DIR == 0 ? LR_O1 : LR_O2));
    const bf16x8 (&fa)[4] = w.fa; const bf16x8 (&fx)[4] = w.fx;
    const int ch = g * 128 + 16 * wid + (lane & 15);
    const float ba = w.ba, bx = w.bx;
    float cl; { const float x = __expf(-w.lm); cl = 8.f * ((x < 0.05f) ? x * (1.f + x * (-0.5f + x * (0.33333334f - 0.25f * x))) : __logf(1.f + x)); }
    f32x4 ar[8], ai_[8];
#pragma unroll
    for (int m = 0; m < 8; ++m) { ar[m] = (f32x4){0.f, 0.f, 0.f, 0.f}; ai_[m] = (f32x4){0.f, 0.f, 0.f, 0.f}; }
#pragma unroll
    for (int m = 0; m < 8; ++m)
#pragma unroll
        for (int ks = 0; ks < 4; ++ks) { const bf16x8 af = *(const bf16x8*)(xcs + (16 * m + (lane & 15)) * 136 + ks * 32 + (lane >> 4) * 8);
            ar[m] = __builtin_amdgcn_mfma_f32_16x16x32_bf16(af, fa[ks], ar[m], 0, 0, 0); ai_[m] = __builtin_amdgcn_mfma_f32_16x16x32_bf16(af, fx[ks], ai_[m], 0, 0, 0); }
    float av[8][4], bv[8][4], hv[8][4], pv[8][4];
#pragma unroll
    for (int m = 0; m < 8; ++m)
#pragma unroll
        for (int j = 0; j < 4; ++j) { const int tt = 16 * m + 4 * (lane >> 4) + j; const float xc = bf1(xcs[tt * 136 + 16 * wid + (lane & 15)]);
            const float r = sigmoidf_(ar[m][j] + ba), ii = sigmoidf_(ai_[m][j] + bx);
            const float la = -cl * r; const float a = __expf(la); const float mult = __builtin_amdgcn_sqrtf(fmaxf(1.f - a * a, 0.f));
            av[m][j] = a; bv[m][j] = mult * ii * xc; }
    float ptot, hend;
    lru_scan_chunk<DIR>(av, bv, hv, pv, ptot, hend, lane);
#pragma unroll
    for (int m = 0; m < 8; ++m)
#pragma unroll
        for (int j = 0; j < 4; ++j) { const int tt = 16 * m + 4 * (lane >> 4) + j; po[tt * 136 + 16 * wid + (lane & 15)] = f2bf(pv[m][j]);
            if (DIR == 0) hsum[m][j] = hv[m][j]; else hsum[m][j] += hv[m][j]; }
    if (lane < 16) { GAS f32x2* sp = (GAS f32x2*)(p.ws + WS_SUM) + ((size_t)((bl * 2 + DIR) * 34 + cidx)) * D + ch; *sp = (f32x2){ptot, hend}; }
}

__device__ __forceinline__ void lru_s1_item(const DP& p, unsigned char* smem, int l, int bl, int g, int cidx) {
    const int tid = opq_v(threadIdx.x), lane = tid & 63; const int wid = __builtin_amdgcn_readfirstlane(tid >> 6);
    const GAS bf16_t* z = (const GAS bf16_t*)(p.ws + WS_Z);
    const int rowb = bl * RB;
    bf16_t* raw = (bf16_t*)(smem + LR_RAW); bf16_t* xcs = (bf16_t*)(smem + LR_XC);
    const int c8 = (tid & 15) * 8;
    const bool is_ctx = cidx < 2; const int seqbase = rowb + (is_ctx ? 0 : CL), Tseq = is_ctx ? CL : T, t0 = is_ctx ? cidx * 128 : (cidx - 2) * 128;
    LruW w0, w1;
    lru_load_w(p, l, 0, g, lane, wid, w0); lru_load_w(p, l, 1, g, lane, wid, w1);
    { u32x4 rv[5];
#pragma unroll
      for (int k = 0; k < 5; ++k) { const int i = tid + k * NTHR; const int rr = i >> 4, cc = (i & 15) * 8; const int t = t0 - 2 + rr;
          rv[k] = (u32x4){0u, 0u, 0u, 0u};
          if (i < 132 * 16 && t >= 0 && t < Tseq) rv[k] = *(const GAS u32x4*)(z + (size_t)(seqbase + t) * DIN + ZC_AX + g * 128 + cc); }
#pragma unroll
      for (int k = 0; k < 5; ++k) { const int i = tid + k * NTHR; const int rr = i >> 4, cc = (i & 15) * 8; if (i < 132 * 16) *(u32x4*)(raw + rr * 128 + cc) = rv[k]; } }
    float cw[4][8], cbv[8];
    { const GAS float* w = p.in[I_CONVW] + (size_t)l * 4 * D + g * 128 + c8; const GAS float* b = p.in[I_CONVB] + l * D + g * 128 + c8;
#pragma unroll
      for (int k = 0; k < 4; ++k)
#pragma unroll
          for (int i = 0; i < 8; ++i) cw[k][i] = w[k * D + i];
#pragma unroll
      for (int i = 0; i < 8; ++i) cbv[i] = b[i]; }
    __syncthreads();
#pragma unroll
    for (int j = 0; j < 4; ++j) { const int idx = tid + NTHR * j; const int tt = idx >> 4;
        float accv[8];
#pragma unroll
        for (int i = 0; i < 8; ++i) accv[i] = cbv[i];
#pragma unroll
        for (int k = 0; k < 4; ++k) { float xv[8]; unpack8(*(const u32x4*)(raw + (tt + k) * 128 + c8), xv);
#pragma unroll
            for (int i = 0; i < 8; ++i) accv[i] += xv[i] * cw[k][i]; }
        u32x4 w; w.x = pk_bf16(accv[0], accv[1]); w.y = pk_bf16(accv[2], accv[3]); w.z = pk_bf16(accv[4], accv[5]); w.w = pk_bf16(accv[6], accv[7]);
        *(u32x4*)(xcs + tt * 136 + c8) = w; }
    __syncthreads();
    float hsum[8][4];
    lru_dir<0>(p, smem, l, bl, g, cidx, hsum, lane, wid, w0);
    lru_dir<1>(p, smem, l, bl, g, cidx, hsum, lane, wid, w1);
    { bf16_t* o0 = (bf16_t*)(smem + LR_RAW);
#pragma unroll
      for (int m = 0; m < 8; ++m)
#pragma unroll
          for (int j = 0; j < 4; ++j) { const int tt = 16 * m + 4 * (lane >> 4) + j; o0[tt * 136 + 16 * wid + (lane & 15)] = f2bf(hsum[m][j]); } }
    __syncthreads();
    { GAS bf16_t* ain = (GAS bf16_t*)(p.ws + WS_AIN); GAS bf16_t* pfb = (GAS bf16_t*)(p.ws + WS_MB); GAS bf16_t* pbb = (GAS bf16_t*)(p.ws + WS_PB);
#pragma unroll
      for (int j = 0; j < 4; ++j) { const int idx = tid + NTHR * j; const int tt = idx >> 4;
          const size_t off = (size_t)(seqbase + t0 + tt) * D + g * 128 + c8;
          *(GAS u32x4*)(ain + off) = *(const u32x4*)(smem + LR_RAW + (tt * 136 + c8) * 2);
          *(GAS u32x4*)(pfb + off) = *(const u32x4*)(smem + LR_O1 + (tt * 136 + c8) * 2);
          *(GAS u32x4*)(pbb + off) = *(const u32x4*)(smem + LR_O2 + (tt * 136 + c8) * 2); } }
    __syncthreads();
}

__device__ __forceinline__ void lru_combine_item(const DP& p, unsigned char* smem, int bl, int cidx, int g) {
    const int tid = opq_v(threadIdx.x);
    const GAS bf16_t* z = (const GAS bf16_t*)(p.ws + WS_Z);
    GAS bf16_t* ain = (GAS bf16_t*)(p.ws + WS_AIN); const GAS bf16_t* pfb = (const GAS bf16_t*)(p.ws + WS_MB); const GAS bf16_t* pbb = (const GAS bf16_t*)(p.ws + WS_PB);
    float* cin = (float*)smem;
    if (tid < 256) { const int dir = tid >> 7, chl = tid & 127;
        const GAS f32x2* S = (const GAS f32x2*)(p.ws + WS_SUM) + (size_t)((bl * 2 + dir) * 34) * D + g * 128 + chl;
        const int npos = (dir == 0) ? cidx : ((cidx < 2) ? 1 - cidx : 35 - cidx);
        f32x2 sv[34];
#pragma unroll
        for (int k = 0; k < 34; ++k) { const int cc = (dir == 0) ? k : ((k < 2) ? 1 - k : 35 - k); sv[k] = (k < npos) ? S[(size_t)cc * D] : (f32x2){1.f, 0.f}; }
        float h = 0.f;
#pragma unroll
        for (int k = 0; k < 34; ++k) h = sv[k][0] * h + sv[k][1];
        cin[dir * 128 + chl] = h; }
    __syncthreads();
    const int row0 = bl * RB + (cidx < 2 ? cidx * 128 : CL + (cidx - 2) * 128);
    const int c8 = (tid & 15) * 8;
    float cf[8], cb[8];
#pragma unroll
    for (int i = 0; i < 8; ++i) { cf[i] = cin[c8 + i]; cb[i] = cin[128 + c8 + i]; }
#pragma unroll
    for (int j = 0; j < 4; ++j) { const int idx = tid + NTHR * j; const int tt = idx >> 4;
        const size_t grow = (size_t)(row0 + tt); const size_t off = grow * D + g * 128 + c8;
        float u[8], pf[8], pb[8], gg[8]; unpack8(*(const GAS u32x4*)(ain + off), u); unpack8(*(const GAS u32x4*)(pfb + off), pf); unpack8(*(const GAS u32x4*)(pbb + off), pb);
        unpack8(*(const GAS u32x4*)(z + grow * DIN + ZC_AG + g * 128 + c8), gg);
#pragma unroll
        for (int i = 0; i < 8; ++i) u[i] = (u[i] + pf[i] * cf[i] + pb[i] * cb[i]) * siluf_(gg[i]);
        u32x4 w; w.x = pk_bf16(u[0], u[1]); w.y = pk_bf16(u[2], u[3]); w.z = pk_bf16(u[4], u[5]); w.w = pk_bf16(u[6], u[7]);
        *(GAS u32x4*)(ain + off) = w; }
    __syncthreads();
}

constexpr int SG_STAT = 0;
constexpr int SG_VN = 2048;
__device__ __forceinline__ void sgu_item(const DP& p, unsigned char* smem, int l, int bl, int chunk) {
    const int tid = opq_v(threadIdx.x), lane = tid & 63, r32 = lane & 31, hi = lane >> 5; const int wid = __builtin_amdgcn_readfirstlane(tid >> 6);
    LAS unsigned char* lds3 = (LAS unsigned char*)smem;
    const GAS bf16_t* z = (const GAS bf16_t*)(p.ws + WS_Z);
    GAS bf16_t* cin = (GAS bf16_t*)(p.ws + WS_AIN) + (size_t)2 * RG * D;
    const int row0 = bl * RB + (chunk < 2 ? chunk * 128 : CL + (chunk - 2) * 128);
    float* stat = (float*)(smem + SG_STAT);
#pragma unroll
    for (int hb = 0; hb < 2; ++hb) {
        u32x4 ra[8], rb[8];
#pragma unroll
        for (int i = 0; i < 8; ++i) { const GAS bf16_t* vr = z + (size_t)(row0 + wid * 16 + hb * 8 + i) * DIN + ZC_CV; ra[i] = *(const GAS u32x4*)(vr + lane * 8); rb[i] = *(const GAS u32x4*)(vr + 512 + lane * 8); }
        float s1[8], s2[8];
#pragma unroll
        for (int i = 0; i < 8; ++i) { float a[8], b[8]; unpack8(ra[i], a); unpack8(rb[i], b); float t1 = 0.f, t2 = 0.f;
#pragma unroll
            for (int k = 0; k < 8; ++k) { t1 += a[k] + b[k]; t2 += a[k] * a[k] + b[k] * b[k]; }
            s1[i] = t1; s2[i] = t2; }
#pragma unroll
        for (int o = 1; o < 64; o <<= 1)
#pragma unroll
            for (int i = 0; i < 8; ++i) { s1[i] += __shfl_xor(s1[i], o); s2[i] += __shfl_xor(s2[i], o); }
        if (lane < 8) { float m1 = 0.f, m2 = 0.f;
#pragma unroll
            for (int i = 0; i < 8; ++i) if (lane == i) { m1 = s1[i]; m2 = s2[i]; }
            const float mean = m1 * (1.f / D); const float var = fmaxf(m2 * (1.f / D) - mean * mean, 0.f);
            const int tk = wid * 16 + hb * 8 + lane; stat[tk * 2] = mean; stat[tk * 2 + 1] = 1.f / sqrtf(var + 1e-5f); }
    }
    __syncthreads();
    const int pblk = wid & 3, cb0 = (wid >> 2) * 2;
    const unsigned laneaddr = ((lane >> 4) & 1) * 32 + (lane & 3) * 8 + (4 * hi + ((lane & 15) >> 2)) * 64;
    for (int g = 0; g < 8; ++g) {
        unsigned char* vn = smem + SG_VN + (g & 1) * 32768;
        { const int c8 = (tid & 15) * 8; float lg[8], lb[8];
          const GAS float* lgp = p.in[I_SLG] + l * D + g * 128 + c8; const GAS float* lbp = p.in[I_SLB] + l * D + g * 128 + c8;
          const f32x4 g0 = *(const GAS f32x4*)lgp, g1 = *(const GAS f32x4*)(lgp + 4), b0 = *(const GAS f32x4*)lbp, b1 = *(const GAS f32x4*)(lbp + 4);
#pragma unroll
          for (int i = 0; i < 4; ++i) { lg[i] = g0[i]; lg[4 + i] = g1[i]; lb[i] = b0[i]; lb[4 + i] = b1[i]; }
          u32x4 rv[4];
#pragma unroll
          for (int j = 0; j < 4; ++j) { const int qq = (tid + NTHR * j) >> 4; rv[j] = *(const GAS u32x4*)(z + (size_t)(row0 + qq) * DIN + ZC_CV + g * 128 + c8); }
#pragma unroll
          for (int j = 0; j < 4; ++j) { const int qq = (tid + NTHR * j) >> 4; float v[8]; unpack8(rv[j], v);
              const float mean = stat[qq * 2], rstd = stat[qq * 2 + 1];
#pragma unroll
              for (int i = 0; i < 8; ++i) v[i] = (v[i] - mean) * rstd * lg[i] + lb[i];
              u32x4 w; w.x = pk_bf16(v[0], v[1]); w.y = pk_bf16(v[2], v[3]); w.z = pk_bf16(v[4], v[5]); w.w = pk_bf16(v[6], v[7]);
              *(u32x4*)(vn + ((c8 >> 5) * 8 + (qq >> 4)) * 1024 + (qq & 15) * 64 + (c8 & 31) * 2) = w; } }
        const GAS bf16_t* wp = (const GAS bf16_t*)(p.ws + WS_SGUW) + (size_t)(l * 8 + g) * 16384 + (size_t)(32 * pblk + r32) * 128 + 4 * hi;
        u32x2 wlo[8], whi[8];
#pragma unroll
        for (int ks = 0; ks < 8; ++ks) { wlo[ks] = *(const GAS u32x2*)(wp + 16 * ks); whi[ks] = *(const GAS u32x2*)(wp + 16 * ks + 8); }
        __syncthreads();
        f32x16 acc[2]; acc[0] = f32x16{}; acc[1] = f32x16{};
        LAS const unsigned char* vb = lds3 + SG_VN + (g & 1) * 32768 + laneaddr;
#pragma unroll
        for (int ks = 0; ks < 8; ++ks) { const u32x4 aw = (u32x4){wlo[ks][0], wlo[ks][1], whi[ks][0], whi[ks][1]};
#pragma unroll
            for (int cb = 0; cb < 2; ++cb) { const s16x4 lo = vtr(vb + ((cb0 + cb) * 8 + ks) * 1024), hh = vtr(vb + ((cb0 + cb) * 8 + ks) * 1024 + 512);
                acc[cb] = __builtin_amdgcn_mfma_f32_32x32x16_bf16(__builtin_bit_cast(bf16x8, aw), (bf16x8){lo[0], lo[1], lo[2], lo[3], hh[0], hh[1], hh[2], hh[3]}, acc[cb], 0, 0, 0); } }
        const GAS float* bsp = p.in[I_SB] + (size_t)(l * 8 + g) * 128 + 32 * pblk;
#pragma unroll
        for (int r = 0; r < 16; ++r) { const int pp = crow(r, hi); const float bs = bsp[pp]; const size_t grow = (size_t)(row0 + 32 * pblk + pp);
#pragma unroll
            for (int cb = 0; cb < 2; ++cb) { const int col = g * 128 + 32 * (cb0 + cb) + r32;
                const float u = bf1(z[grow * DIN + ZC_CU + col]), gate = bf1(z[grow * DIN + ZC_CG + col]);
                cin[grow * D + col] = f2bf(u * (acc[cb][r] + bs) * siluf_(gate)); } }
    }
    __syncthreads();
}

__device__ __forceinline__ void phase_mixers(const DP& p, unsigned char* smem, int grp, int l, int rep = 0) {
    const int tid = threadIdx.x;
    GAS unsigned* ctr = (GAS unsigned*)(p.ws + WS_CTL) + (grp * NL + l) * 64 + rep * 32;
    volatile int* sh = (volatile int*)(smem + LDS_IDX_OFF);
    const int nq = (l == 0) ? 17 : 16, nch = (l == 0) ? 34 : 32;
    const int n_att = GB * 8 * nq, n_lru = GB * 8 * 34, n_sgu = GB * nch, total = n_lru + n_att + n_sgu;
    for (;;) {
        __syncthreads();
        if (tid == 0) *sh = (int)atomicAdd((unsigned*)ctr, 1u);
        __syncthreads();
        const int idx = *sh;
        if (idx >= total) break;
        if (idx < n_sgu) { const int cc = idx; int chn, bl; if (l == 0) { chn = cc % 34; bl = cc / 34; } else { chn = cc & 31; bl = cc >> 5; } sgu_item(p, smem, l, bl, (l == 0) ? chn : chn + 2); }
        else if (idx < n_sgu + n_att) { const int a = idx - n_sgu; int qi, bh; if (l == 0) { qi = a % 17; bh = a / 17; } else { qi = a & 15; bh = a >> 4; } attn_unit(p, smem, l, bh >> 3, bh & 7, (l == 0) ? qi : qi + 1); }
        else { const int a = idx - n_att - n_sgu; const int g = a & 7, cc = a >> 3; lru_s1_item(p, smem, l, cc / 34, g, cc % 34); }
    }
}
__device__ __forceinline__ void phase_combine(const DP& p, unsigned char* smem) {
    for (int it = blockIdx.x; it < GB * 34 * 8; it += gridDim.x) { const int g = it & 7, cc = it >> 3; lru_combine_item(p, smem, cc / 34, cc % 34, g); }
}

#define XB_TMO      128
#define XB_XCNT(j)  (256  + 64 * (j))
#define XB_XSUB(j)  (1280 + 64 * (j))
#define XB_XGEN(j)  (2304 + 64 * (j))
#define XB_TOP      3328
#define XB_TOPGEN   3392
#define XCD_BAR_WORDS 3456
#define XB_SPIN_CAP (1u << 22)
__device__ __forceinline__ unsigned xb_ld(unsigned* p)              { return __hip_atomic_load(p, __ATOMIC_RELAXED, __HIP_MEMORY_SCOPE_AGENT); }
__device__ __forceinline__ unsigned xb_add(unsigned* p, unsigned v) { return __hip_atomic_fetch_add(p, v, __ATOMIC_RELAXED, __HIP_MEMORY_SCOPE_AGENT); }
__device__ __forceinline__ unsigned xb_xcc_id() { return (unsigned)__builtin_amdgcn_s_getreg((3 << 11) | 20) & 0xFu; }
#define XB_SPIN(cond, bar) do { unsigned _sp = 0; while (cond) { __builtin_amdgcn_s_sleep(1); \
    if ((++_sp & 255u) == 0u) { if (xb_ld(&(bar)[XB_TMO])) break; if (_sp > XB_SPIN_CAP) { atomicAdd(&(bar)[XB_TMO], 1u); break; } } } } while (0)
struct XcdBarrier { unsigned* bar; unsigned x; volatile LAS unsigned* st; };
__device__ __forceinline__ XcdBarrier xcd_barrier_post(unsigned* bar, volatile LAS unsigned* st) {
    XcdBarrier b; b.bar = bar; b.x = xb_xcc_id(); b.st = st;
    if (threadIdx.x == 0) (void)xb_add(&bar[XB_XCNT(b.x)], 1u);
    return b;
}
__device__ __forceinline__ void xcd_barrier_complete(unsigned* bar, unsigned x, unsigned& nloc, unsigned& nx) {
    const unsigned G = gridDim.x * gridDim.y * gridDim.z;
    unsigned sum, cnt, mine, sp = 0u;
    for (;;) {
        sum = 0u; cnt = 0u; mine = 0u;
#pragma unroll
        for (unsigned j = 0; j < 16; ++j) { const unsigned c = xb_ld(&bar[XB_XCNT(j)]); sum += c; cnt += (c > 0u) ? 1u : 0u; mine = (j == x) ? c : mine; }
        if (sum == G) break;
        __builtin_amdgcn_s_sleep(1);
        if ((++sp & 255u) == 0u) { if (xb_ld(&bar[XB_TMO])) break; if (sp > XB_SPIN_CAP) { atomicAdd(&bar[XB_TMO], 1u); break; } }
    }
    nloc = mine > 0u ? mine : 1u; nx = cnt > 0u ? cnt : 1u;
}
__device__ __forceinline__ void xcd_barrier(const XcdBarrier& b) {
    asm volatile("s_waitcnt vmcnt(0)" ::: "memory");
    __syncthreads();
    if (threadIdx.x == 0) {
        unsigned* bar = b.bar;
        __builtin_amdgcn_s_waitcnt(0);
        unsigned nloc = b.st[0], nx = b.st[1];
        if (nloc == 0u) { xcd_barrier_complete(bar, b.x, nloc, nx); b.st[0] = nloc; b.st[1] = nx; }
        const unsigned old = xb_add(&bar[XB_XSUB(b.x)], 1u);
        const unsigned gen = old / nloc;
        if (old + 1u == (gen + 1u) * nloc) {
            __builtin_amdgcn_fence(__ATOMIC_RELEASE, "agent");
            asm volatile("s_waitcnt vmcnt(0)" ::: "memory");
            const unsigned og = xb_add(&bar[XB_TOP], 1u);
            const unsigned tg = og / nx;
            if (og + 1u == (tg + 1u) * nx) xb_add(&bar[XB_TOPGEN], 1u);
            else XB_SPIN(xb_ld(&bar[XB_TOPGEN]) == tg, bar);
            __builtin_amdgcn_fence(__ATOMIC_ACQUIRE, "agent");
            xb_add(&bar[XB_XGEN(b.x)], 1u);
            asm volatile("s_waitcnt vmcnt(0)" ::: "memory");
        } else {
            XB_SPIN(xb_ld(&bar[XB_XGEN(b.x)]) == gen, bar);
            __builtin_amdgcn_fence(__ATOMIC_ACQUIRE, "agent");
            asm volatile("s_waitcnt vmcnt(0)" ::: "memory");
        }
    }
    __syncthreads();
}

struct EpiOutLN {
    static constexpr bool PERM = true;
    const GAS float* srcX; GAS float* dstX; const GAS float* mod; const GAS float* lng; const GAS float* lnb; GAS f32x2* stats; unsigned char* smem; unsigned* bar; int grp;
    GAS bf16_t* xm; const GAS float* mod1;
    __device__ __forceinline__ void operator()(f32x4 (&acc)[2][2][4][2], const pg8::Unit& u, int wr, int wc, int fr, int fq) const {
        using namespace pg8;
        const int bl = u.rm / TILES_B, tt = u.rm % TILES_B, b = grp * GB + bl;
        const int col0 = u.rn * BM + wc * 32 + 8 * fq;
        f32x2* P = (f32x2*)(smem + 131072);
        f32x2* S = (f32x2*)(smem + 131072 + 8192);
        { const GAS float* gt = mod + (size_t)b * 3072 + 2048 + col0;
#pragma unroll
          for (int ai = 0; ai < 2; ++ai)
#pragma unroll
            for (int m = 0; m < 4; ++m) {
                const int rit = ai * HALF + wr * 64 + m * 16 + fr;
                const GAS float* sp = srcX + ((size_t)b * T + (tt - 1) * 256 + rit) * D + col0;
                float sm = 0.f, sq = 0.f;
#pragma unroll
                for (int bj = 0; bj < 2; ++bj)
#pragma unroll
                    for (int n = 0; n < 2; ++n) { const f32x4 xr = *(const GAS f32x4*)(sp + bj * HALF + 4 * n); const f32x4 gv = *(const GAS f32x4*)(gt + bj * HALF + 4 * n);
                        const f32x4 v = xr * ALPHA + gv * acc[ai][bj][m][n]; acc[ai][bj][m][n] = v;
                        sm += (v[0] + v[1]) + (v[2] + v[3]); sq += (v[0] * v[0] + v[1] * v[1]) + (v[2] * v[2] + v[3] * v[3]); }
                sm += __shfl_xor(sm, 16); sm += __shfl_xor(sm, 32); sq += __shfl_xor(sq, 16); sq += __shfl_xor(sq, 32);
                if (fq == 0) P[rit * 4 + wc] = (f32x2){sm, sq};
            } }
        __syncthreads();
        const int tid = threadIdx.x;
        if (tid < 256) { const f32x2 a = P[tid * 4], b2 = P[tid * 4 + 1], c = P[tid * 4 + 2], d = P[tid * 4 + 3];
            stats[(size_t)(u.rm * BM + tid) * 4 + u.rn] = (f32x2){(a[0] + b2[0]) + (c[0] + d[0]), (a[1] + b2[1]) + (c[1] + d[1])}; }
        { XcdBarrier xb_; xb_.bar = bar; xb_.x = xb_xcc_id(); xb_.st = (volatile LAS unsigned*)((LAS unsigned char*)smem + LDS_IDX_OFF + 16); xcd_barrier(xb_); }
        if (tid < 256) { const GAS f32x2* sp = stats + (size_t)(u.rm * BM + tid) * 4; const f32x2 a = sp[0], b2 = sp[1], c = sp[2], d = sp[3];
            const float mean = ((a[0] + b2[0]) + (c[0] + d[0])) * (1.f / D); const float var = fmaxf(((a[1] + b2[1]) + (c[1] + d[1])) * (1.f / D) - mean * mean, 0.f);
            S[tid] = (f32x2){mean, 1.f / sqrtf(var + 1e-5f)}; }
        __syncthreads();
        f32x4 g4[2][2], b4[2][2];
#pragma unroll
        for (int bj = 0; bj < 2; ++bj)
#pragma unroll
            for (int n = 0; n < 2; ++n) { g4[bj][n] = *(const GAS f32x4*)(lng + col0 + bj * HALF + 4 * n); b4[bj][n] = *(const GAS f32x4*)(lnb + col0 + bj * HALF + 4 * n); }
#pragma unroll
        for (int ai = 0; ai < 2; ++ai)
#pragma unroll
            for (int m = 0; m < 4; ++m) {
                const int rit = ai * HALF + wr * 64 + m * 16 + fr; const f32x2 ms = S[rit];
                GAS float* dp = dstX + ((size_t)b * T + (tt - 1) * 256 + rit) * D + col0;
#pragma unroll
                for (int bj = 0; bj < 2; ++bj) {
                    const f32x4 o0 = (acc[ai][bj][m][0] - ms[0]) * ms[1] * g4[bj][0] + b4[bj][0], o1 = (acc[ai][bj][m][1] - ms[0]) * ms[1] * g4[bj][1] + b4[bj][1];
                    *(GAS f32x4*)(dp + bj * HALF) = o0; *(GAS f32x4*)(dp + bj * HALF + 4) = o1;
                    if (xm) { const GAS float* md = mod1 + (size_t)b * 3072 + col0 + bj * HALF;
                        const f32x4 sh0 = *(const GAS f32x4*)md, sh1 = *(const GAS f32x4*)(md + 4), sc0 = *(const GAS f32x4*)(md + 1024), sc1 = *(const GAS f32x4*)(md + 1028);
                        const f32x4 r0 = o0 * (sc0 + 1.f) + sh0, r1 = o1 * (sc1 + 1.f) + sh1;
                        u32x4 w; w.x = pk_bf16(r0[0], r0[1]); w.y = pk_bf16(r0[2], r0[3]); w.z = pk_bf16(r1[0], r1[1]); w.w = pk_bf16(r1[2], r1[3]);
                        *(GAS u32x4*)(xm + (size_t)(u.rm * BM + rit) * D + col0 + bj * HALF) = w; } }
            }
    }
};
struct SchedCtx { int G, c;
    __device__ bool next(int i, pg8::Unit& u) const { const int ti = i * G + c; if (ti >= GB * 4) return false;
        u.rm = (ti >> 2) * TILES_B; u.rn = ti & 3; u.br = 0; u.xb = -1; u.pm = u.rm; u.pn = u.rn; return true; } };

__global__ void __launch_bounds__(NTHR, 2) fwd_megakernel(Params p) {
    extern __shared__ __attribute__((aligned(16))) unsigned char smem[];
    cg::grid_group grid = cg::this_grid();
    if (threadIdx.x < 2) ((volatile LAS unsigned*)((LAS unsigned char*)smem + LDS_IDX_OFF + 16))[threadIdx.x] = 0u;
    __syncthreads();
    (void)xcd_barrier_post((unsigned*)(p.ws + WS_CTL + 16384), (volatile LAS unsigned*)((LAS unsigned char*)smem + LDS_IDX_OFF + 16));
#define GRID_BAR() do { XcdBarrier xb_; xb_.bar = (unsigned*)(opq_p(p.ws) + WS_CTL + 16384); xb_.x = xb_xcc_id(); xb_.st = (volatile LAS unsigned*)((LAS unsigned char*)smem + LDS_IDX_OFF + 16); xcd_barrier(xb_); } while (0)
    LAS unsigned char* lds3 = (LAS unsigned char*)smem;
#define MAKE_DP(q) DP q; _Pragma("unroll") for (int i_ = 0; i_ < 25; ++i_) q.in[i_] = (const GAS float*)p.in[i_]; q.out = opq_p((GAS float*)p.out); q.ws = opq_p((GAS unsigned char*)p.ws)
    { MAKE_DP(q); phase_prologue(q, smem); }
    grid.sync();
    { MAKE_DP(q); phase_xm0(q, 0); }
    GRID_BAR();
    for (int grp = 0; grp < NGRP; ++grp) {
        for (int l = 0; l < NL; ++l) {
            const bool last = (l == NL - 1);
            { MAKE_DP(d); GAS unsigned char* ws = d.ws; const int G = opq_s(gridDim.x), c = opq_s(blockIdx.x);
              pg8::Gemm g{(const GAS bf16_t*)(ws + WS_XM), (const GAS bf16_t*)(ws + WS_WIN) + (size_t)l * DIN * D, D};
              pg8::SchedGrid S; S.init(TILES_G, DIN / 256, G, c);
              pg8::EpiInProj E{(GAS bf16_t*)(ws + WS_Z), d.in[I_BIN] + l * DIN, (const GAS float*)(ws + WS_ROPE), (GAS bf16_t*)(ws + WS_KC), (GAS bf16_t*)(ws + WS_VC)};
              pg8::gemm_phase<pg8::EpiInProj, pg8::SchedGrid, false, true>(lds3, g, S, E); }
            GRID_BAR();
            { MAKE_DP(q); phase_mixers(q, smem, opq_s(grp), opq_s(l)); }
            GRID_BAR();
            { MAKE_DP(q); phase_combine(q, smem); }
            GRID_BAR();
            { MAKE_DP(d); GAS unsigned char* ws = d.ws; const int G = opq_s(gridDim.x), c = opq_s(blockIdx.x);
              pg8::Gemm g{(const GAS bf16_t*)(ws + WS_AIN), (const GAS bf16_t*)(ws + WS_WBR) + (size_t)l * 3 * D * D, D};
              pg8::SchedRows<3> S; S.init(true, G, c, !last);
              pg8::EpiMerge E{(const GAS bf16_t*)(ws + WS_Z), (GAS bf16_t*)(ws + WS_MB), (GAS float*)(ws + WS_PART)};
              pg8::gemm_phase<pg8::EpiMerge, pg8::SchedRows<3>>(lds3, g, S, E); }
            GRID_BAR();
            if (!last) { MAKE_DP(d);
              for (int gid = (int)blockIdx.x * NTHR + opq_v(threadIdx.x); gid < GB * CL * (D / 8); gid += (int)gridDim.x * NTHR) { const int r = gid >> 7, c8 = (gid & 127) * 8; const GAS float* pp = (const GAS float*)(d.ws + WS_PART) + (size_t)r * D + c8; const size_t bs = (size_t)GB * CL * D;
                  const f32x4 a0 = *(const GAS f32x4*)pp, a1 = *(const GAS f32x4*)(pp + 4), b0 = *(const GAS f32x4*)(pp + bs), b1 = *(const GAS f32x4*)(pp + bs + 4), c0 = *(const GAS f32x4*)(pp + 2 * bs), c1 = *(const GAS f32x4*)(pp + 2 * bs + 4);
                  const f32x4 s0 = (a0 + b0) + c0, s1 = (a1 + b1) + c1; u32x4 w; w.x = pk_bf16(s0[0], s0[1]); w.y = pk_bf16(s0[2], s0[3]); w.z = pk_bf16(s1[0], s1[1]); w.w = pk_bf16(s1[2], s1[3]);
                  *(GAS u32x4*)((GAS bf16_t*)(d.ws + WS_MB) + ((size_t)(r >> 8) * RB + (r & 255)) * D + c8) = w; } }
            { MAKE_DP(d); GAS unsigned char* ws = d.ws; const int G = opq_s(gridDim.x), c = opq_s(blockIdx.x); GAS float* outp = d.out;
              pg8::Gemm g{(const GAS bf16_t*)(ws + WS_MB), (const GAS bf16_t*)(ws + WS_WOUT) + (size_t)l * D * D, D};
              pg8::SchedRows<1> S; S.init(true, G, c);
              EpiOutLN E{l == 0 ? d.in[I_X] : (const GAS float*)outp, outp, (const GAS float*)(ws + WS_MOD) + (size_t)l * 17 * 3072, d.in[I_LNG] + l * D, d.in[I_LNB] + l * D, (GAS f32x2*)(ws + WS_STATS), smem, (unsigned*)(ws + WS_CTL + 16384), grp,
                         last ? (GAS bf16_t*)nullptr : (GAS bf16_t*)(ws + WS_XM), (const GAS float*)(ws + WS_MOD) + (size_t)(l + 1) * 17 * 3072};
              pg8::gemm_phase<EpiOutLN, pg8::SchedRows<1>>(lds3, g, S, E); }
            if (!last) {
              { MAKE_DP(d); GAS unsigned char* ws = d.ws; const int G = opq_s(gridDim.x), c = opq_s(blockIdx.x);
                pg8::Gemm g{(const GAS bf16_t*)(ws + WS_MB), (const GAS bf16_t*)(ws + WS_WOUT) + (size_t)l * D * D, D};
                SchedCtx S{G, c};
                pg8::EpiOut E{d.in[I_X], l == 0 ? d.in[I_CTX] : (const GAS float*)(ws + WS_CTX1), d.out, (GAS float*)(ws + WS_CTX1), (const GAS float*)(ws + WS_MOD) + (size_t)l * 17 * 3072, grp};
                pg8::gemm_phase<pg8::EpiOut, SchedCtx>(lds3, g, S, E); }
              GRID_BAR();
              { MAKE_DP(q); phase_ln(q, opq_s(grp), opq_s(l), true); }
            }
            if (l == NL - 1 && grp + 1 < NGRP) { MAKE_DP(q); phase_xm0(q, opq_s(grp + 1)); }
            if (!(l == NL - 1 && grp + 1 == NGRP)) GRID_BAR();
        }
    }
}

extern "C" void kernel_launch(void* const* d_in, const int* in_sizes, int n_in, void* d_out, int out_size, void* d_ws, size_t ws_size, hipStream_t stream) {
    static int grid = 0;
    if (grid == 0) {
        if (n_in != 25 || ws_size < WS_END) { fprintf(stderr, "kernel_launch: unexpected n_in %d / ws_size %zu\n", n_in, ws_size); grid = -1; return; }
        int dev = 0, cus = 0, per_cu = 0;
        hipGetDevice(&dev);
        hipDeviceGetAttribute(&cus, hipDeviceAttributeMultiprocessorCount, dev);
        hipFuncSetAttribute((const void*)fwd_megakernel, hipFuncAttributeMaxDynamicSharedMemorySize, LDS_BYTES);
        hipOccupancyMaxActiveBlocksPerMultiprocessor(&per_cu, (const void*)fwd_megakernel, NTHR, LDS_BYTES);
        if (per_cu < 1) { fprintf(stderr, "kernel_launch: occupancy query says %d blocks per CU\n", per_cu); per_cu = 1; }
        (void)hipGetLastError();
        grid = cus;
    }
    if (grid < 0) return;
    hipMemsetAsync((char*)d_ws + WS_CTL, 0, CTL_BYTES, stream);
    Params p{};
    for (int i = 0; i < 25; ++i) p.in[i] = (const float*)d_in[i];
    p.out = (float*)d_out; p.ws = (unsigned char*)d_ws;
    void* args[] = {&p};
    hipError_t e = hipLaunchCooperativeKernel((const void*)fwd_megakernel, dim3(grid), dim3(NTHR), args, LDS_BYTES, stream);
    if (e != hipSuccess) fprintf(stderr, "cooperative launch failed: %s (grid %d)\n", hipGetErrorString(e), grid);
}
```
